# Optimizing an MI355X kernel written in HIP

```python
import math
import jax, jax.numpy as jnp
from jax import lax
import numpy as np

D_MODEL = 2048
BATCH = 4
SEQ = 2048
DEPTH = 2

N_MEM = 256
MIX_WIDTH = D_MODEL
DIFF_V_DIM = 128
DIFF_QK_DIM = DIFF_V_DIM // 2
DIFF_HEADS = (MIX_WIDTH // 2) // DIFF_V_DIM
SB_DIM = 128
SB_HEADS = (MIX_WIDTH // 2) // SB_DIM
X_HEADS = 4
X_DIM = D_MODEL // X_HEADS
D_FF = 4 * D_MODEL
Q_BLOCK = 128
EPS = 1e-6
NEG_INF = -1e30

DIFF_Q_COLS = DIFF_HEADS * 2 * DIFF_QK_DIM
DIFF_V_COLS = DIFF_HEADS * DIFF_V_DIM
SB_COLS = SB_HEADS * SB_DIM
IN_COLS = 2 * DIFF_Q_COLS + DIFF_V_COLS + 3 * SB_COLS

kernel_name = "hymba_diff_stickbreak_alibi_memxattn"


def _rmsnorm(x, g):
    xf = x.astype(jnp.float32)
    y = xf * lax.rsqrt(jnp.mean(xf * xf, axis=-1, keepdims=True) + EPS)
    return (y * g.astype(jnp.float32)).astype(x.dtype)


def _alibi_slopes(n):
    return jnp.asarray(np.array([2.0 ** (-8.0 * (i + 1) / n) for i in range(n)], dtype=np.float32))


def _to_blocks(t):
    b, s = t.shape[:2]
    t = t.reshape((b, s // Q_BLOCK, Q_BLOCK) + t.shape[2:])
    return jnp.moveaxis(t, 1, 0)


def _from_blocks(t):
    t = jnp.moveaxis(t, 0, 1)
    return t.reshape((t.shape[0], t.shape[1] * t.shape[2]) + t.shape[3:])


def _diff_attention(q, k, v, pos, lam, lambda_init, subln_g):
    scale = DIFF_QK_DIM ** -0.5
    slopes = _alibi_slopes(DIFF_HEADS)

    def block(args):
        qb, pq = args
        s = jnp.einsum('bqhmd,bkhmd->bhmqk', qb, k,
                       preferred_element_type=jnp.float32) * scale
        dist = (pq[:, :, None] - pos[:, None, :]).astype(jnp.float32)
        bias = -slopes[None, :, None, None, None] * dist[:, None, None]
        s = jnp.where((dist >= 0)[:, None, None], s + bias, NEG_INF)
        p = jax.nn.softmax(s, axis=-1)
        a = p[:, :, 0] - lam * p[:, :, 1]
        return jnp.einsum('bhqk,bkhd->bqhd', a.astype(v.dtype), v)

    o = _from_blocks(lax.map(block, (_to_blocks(q), _to_blocks(pos))))
    o = _rmsnorm(o, subln_g) * (1.0 - lambda_init)
    return o.reshape(o.shape[0], o.shape[1], DIFF_V_COLS)


def _stick_breaking(q, k, v, pos, out_g):
    scale = SB_DIM ** -0.5

    def block(args):
        qb, pq = args
        z = jnp.einsum('bqhd,bkhd->bhqk', qb, k,
                       preferred_element_type=jnp.float32) * scale
        strict = (pq[:, :, None] > pos[:, None, :])[:, None]
        log_keep = jnp.where(strict, jax.nn.log_sigmoid(-z), 0.0)
        between = lax.cumsum(log_keep, axis=3, reverse=True) - log_keep
        a = jnp.where(strict, jnp.exp(jax.nn.log_sigmoid(z) + between), 0.0)
        return jnp.einsum('bhqk,bkhd->bqhd', a.astype(v.dtype), v)

    o = _from_blocks(lax.map(block, (_to_blocks(q), _to_blocks(pos))))
    o = _rmsnorm(o, out_g)
    return o.reshape(o.shape[0], o.shape[1], SB_COLS)


def _cross_attention(h, m, wq, wkv, wo):
    b, s, _ = h.shape
    q = (h @ wq).reshape(b, s, X_HEADS, X_DIM)
    k, v = jnp.split(m @ wkv, 2, axis=-1)
    k = k.reshape(b, m.shape[1], X_HEADS, X_DIM)
    v = v.reshape(b, m.shape[1], X_HEADS, X_DIM)
    sc = jnp.einsum('bqhd,bkhd->bhqk', q, k, preferred_element_type=jnp.float32) * (X_DIM ** -0.5)
    p = jax.nn.softmax(sc, axis=-1)
    o = jnp.einsum('bhqk,bkhd->bqhd', p.astype(v.dtype), v).reshape(b, s, D_MODEL)
    return o @ wo


def setup_inputs(seed: int = 0) -> dict:
    key = jax.random.key(seed)
    ks = jax.random.split(key, 24)
    f32 = jnp.float32

    def w(k, shape, fan_in):
        return jax.random.normal(k, shape, f32) * (fan_in ** -0.5)

    def gain(k, shape):
        return 1.0 + 0.02 * jax.random.normal(k, shape, f32)

    x = jax.random.normal(ks[0], (BATCH, SEQ, D_MODEL), f32)
    mem = jax.random.normal(ks[1], (BATCH, N_MEM, D_MODEL), f32)
    positions = jnp.broadcast_to(jnp.arange(SEQ, dtype=jnp.int32), (BATCH, SEQ))
    return {
        "x": x,
        "mem": mem,
        "positions": positions,
        "norm_mix": gain(ks[2], (DEPTH, D_MODEL)),
        "w_in": w(ks[3], (DEPTH, D_MODEL, IN_COLS), D_MODEL),
        "lam_q1": 0.1 * jax.random.normal(ks[4], (DEPTH, DIFF_QK_DIM), f32),
        "lam_k1": 0.1 * jax.random.normal(ks[5], (DEPTH, DIFF_QK_DIM), f32),
        "lam_q2": 0.1 * jax.random.normal(ks[6], (DEPTH, DIFF_QK_DIM), f32),
        "lam_k2": 0.1 * jax.random.normal(ks[7], (DEPTH, DIFF_QK_DIM), f32),
        "subln_diff": gain(ks[8], (DEPTH, DIFF_V_DIM)),
        "subln_sb": gain(ks[9], (DEPTH, SB_DIM)),
        "w_out": w(ks[10], (DEPTH, MIX_WIDTH, D_MODEL), MIX_WIDTH),
        "norm_x": gain(ks[11], (DEPTH, D_MODEL)),
        "norm_mem": gain(ks[12], (DEPTH, D_MODEL)),
        "wq_x": w(ks[13], (DEPTH, D_MODEL, D_MODEL), D_MODEL),
        "wkv_x": w(ks[14], (DEPTH, D_MODEL, 2 * D_MODEL), D_MODEL),
        "wo_x": w(ks[15], (DEPTH, D_MODEL, D_MODEL), D_MODEL),
        "norm_mlp": gain(ks[16], (DEPTH, D_MODEL)),
        "w_up": w(ks[17], (DEPTH, D_MODEL, D_FF), D_MODEL),
        "w_down": w(ks[18], (DEPTH, D_FF, D_MODEL), D_FF),
        "norm_final": gain(ks[19], (D_MODEL,)),
    }


def reference(x, mem, positions, norm_mix, w_in, lam_q1, lam_k1, lam_q2, lam_k2,
              subln_diff, subln_sb, w_out, norm_x, norm_mem, wq_x, wkv_x, wo_x,
              norm_mlp, w_up, w_down, norm_final):
    b, s, _ = x.shape
    h = x
    split_at = [DIFF_Q_COLS, 2 * DIFF_Q_COLS, 2 * DIFF_Q_COLS + DIFF_V_COLS,
                2 * DIFF_Q_COLS + DIFF_V_COLS + SB_COLS,
                2 * DIFF_Q_COLS + DIFF_V_COLS + 2 * SB_COLS]
    for l in range(DEPTH):
        lambda_init = 0.8 - 0.6 * math.exp(-0.3 * l)
        u = _rmsnorm(h, norm_mix[l])
        dq, dk, dv, sq, sk, sv = jnp.split(u @ w_in[l], split_at, axis=-1)
        lam = (jnp.exp(jnp.sum(lam_q1[l].astype(jnp.float32) * lam_k1[l].astype(jnp.float32)))
               - jnp.exp(jnp.sum(lam_q2[l].astype(jnp.float32) * lam_k2[l].astype(jnp.float32)))
               + lambda_init)
        o_diff = _diff_attention(dq.reshape(b, s, DIFF_HEADS, 2, DIFF_QK_DIM),
                                 dk.reshape(b, s, DIFF_HEADS, 2, DIFF_QK_DIM),
                                 dv.reshape(b, s, DIFF_HEADS, DIFF_V_DIM),
                                 positions, lam, lambda_init, subln_diff[l])
        o_sb = _stick_breaking(sq.reshape(b, s, SB_HEADS, SB_DIM),
                               sk.reshape(b, s, SB_HEADS, SB_DIM),
                               sv.reshape(b, s, SB_HEADS, SB_DIM),
                               positions, subln_sb[l])
        h = h + jnp.concatenate([o_diff, o_sb], axis=-1) @ w_out[l]
        h = h + _cross_attention(_rmsnorm(h, norm_x[l]), _rmsnorm(mem, norm_mem[l]),
                                 wq_x[l], wkv_x[l], wo_x[l])
        up = _rmsnorm(h, norm_mlp[l]) @ w_up[l]
        h = h + jnp.square(jax.nn.relu(up)) @ w_down[l]
    return _rmsnorm(h, norm_final)
```

```cpp
#include <hip/hip_runtime.h>
#include <hip/hip_cooperative_groups.h>
#include <cstdio>
#include <cstdint>
namespace cg = cooperative_groups;

#define DI __device__ __forceinline__
#define LAS __attribute__((address_space(3)))

constexpr int NB = 4, SEQ = 2048, DM = 2048, TOK = NB * SEQ, INC = 6144, FF = 8192, NMEM = 256, NLAYER = 2;
constexpr int C_DQ = 0, C_DK = 1024, C_DV = 2048, C_SQ = 3072, C_SK = 4096, C_SV = 5120;
constexpr float EPS = 1e-6f, LOG2E = 1.4426950408889634f, LN2 = 0.6931471805599453f;

constexpr size_t MiB = 1u << 20;
constexpr size_t WS_WT = 0;
constexpr size_t WT_IN = 0, WT_OUT = 24 * MiB, WT_Q = 32 * MiB, WT_KV = 40 * MiB, WT_O = 56 * MiB, WT_UP = 64 * MiB, WT_DOWN = 96 * MiB, WT_LAYER = 128 * MiB;
constexpr size_t WS_XN = 256 * MiB;
constexpr size_t WS_RA = 288 * MiB;
constexpr size_t WS_MEMN = 416 * MiB;
constexpr size_t WS_KVX = 424 * MiB;
constexpr size_t WS_SMALL = 440 * MiB;
constexpr size_t WS_QKW = 441 * MiB;
constexpr size_t WS_VW = 473 * MiB;
constexpr size_t WS_SS = 505 * MiB;
constexpr size_t WS_END = 513 * MiB;

namespace pg8 {
typedef unsigned short bf16_t;
typedef short bf16x8 __attribute__((ext_vector_type(8)));
typedef float f32x4 __attribute__((ext_vector_type(4)));
typedef unsigned u32x4 __attribute__((ext_vector_type(4)));
constexpr int BM = 256, BK = 64, HALF = 128, HTB = HALF * BK * 2, STAGE_BYTES = 8 * HTB, NXCD = 8, WGM = 8;

DI int lds_byte(int r, int c) { const int st = (r >> 4) * 2 + (c >> 5), rr = r & 15, cc = c & 31, ob = rr * 64 + cc * 2; return st * 1024 + (ob ^ (((ob >> 9) & 1) << 5)); }
DI void stage_rc(int b, int& R, int& C) { const int st = b / 1024, sb = b % 1024, swz = sb ^ (((sb >> 9) & 1) << 5); R = (st >> 1) * 16 + swz / 64; C = (st & 1) * 32 + (swz % 64) / 2; }
DI int perm32(int rho) { const int n = rho >> 4, i = rho & 15; return 8 * (i >> 2) + 4 * n + (i & 3); }

struct Unit { int pm, pn, z; };
template <int ZDIV, long S0, long S1> struct ZOffT { static DI long off(int z) { return (long)(z / ZDIV) * S0 + (long)(z % ZDIV) * S1; } };
struct ZNone { static DI long off(int) { return 0; } };

struct Order {
    int nM, nN, nZ, nwg, G, c;
    DI void init(int M, int N, int Z, int G_, int c_) { nM = M / BM; nN = N / BM; nZ = Z; nwg = nM * nN * Z; G = G_; c = c_; }
    DI bool next(int i, Unit& u) const {
        const long L = (long)i * G + c; if (L >= nwg) return false;
        int wgid = (int)L; { const int q = nwg / NXCD, r = nwg % NXCD, xcd = wgid % NXCD, off = wgid / NXCD; wgid = (xcd < r ? xcd * (q + 1) : r * (q + 1) + (xcd - r) * q) + off; }
        if (nZ == 1) {
            const int nig = WGM * nN, gid = wgid / nig, fm = gid * WGM, gsz = (nM - fm) < WGM ? (nM - fm) : WGM;
            u.pm = fm + ((wgid % nig) % gsz); u.pn = (wgid % nig) / gsz; u.z = 0;
        } else {
            const int per = nM * nN; u.z = wgid / per; const int r = wgid % per; u.pn = r % nN; u.pm = r / nN;
        }
        return true;
    }
};

DI float row_ss(const float* ssp, int row, int fq) {
    const f32x4* p = (const f32x4*)(ssp + (size_t)row * 32 + fq * 8); const f32x4 a = p[0], b = p[1];
    float s = ((a[0] + a[1]) + (a[2] + a[3])) + ((b[0] + b[1]) + (b[2] + b[3]));
    s += __shfl_xor(s, 16); s += __shfl_xor(s, 32); return s;
}
DI unsigned cvt_pk_bf16(float lo, float hi) { unsigned r; asm volatile("v_cvt_pk_bf16_f32 %0, %1, %2" : "=v"(r) : "v"(lo), "v"(hi)); return r; }

template <class ZO> struct EpiBf16 {
    static constexpr bool PERM = true;
    bf16_t* O; int ldc; int act; const float* ss; int qmode;
    DI void operator()(const f32x4 (&acc)[2][2][4][2], const Unit& u, int wr, int wc, int fr, int fq) const {
        const int row0 = u.pm * BM + wr * 64 + fr; const int col0 = u.pn * BM + wc * 32 + 8 * fq;
        bf16_t* base = O + ZO::off(u.z);
        const float cs = (qmode == 1) ? (u.pn < 4 ? 0.125f * 1.4426950408889634f : (u.pn >= 12 && u.pn < 16) ? 0.08838834764831845f * 1.4426950408889634f : 1.0f) : 1.0f;
#pragma unroll
        for (int ai = 0; ai < 2; ++ai)
#pragma unroll
            for (int m = 0; m < 4; ++m) { bf16_t* rowp = base + (size_t)(row0 + ai * HALF + m * 16) * ldc + col0;
                const float rs = (ss ? 1.0f / sqrtf(row_ss(ss, row0 + ai * HALF + m * 16, fq) * (1.f / 2048.f) + 1e-6f) : 1.0f) * cs;
#pragma unroll
                for (int bj = 0; bj < 2; ++bj) { f32x4 v0 = acc[ai][bj][m][0] * rs, v1 = acc[ai][bj][m][1] * rs;
                    if (act == 1) {
#pragma unroll
                        for (int e = 0; e < 4; ++e) { const float a = fmaxf(v0[e], 0.f), b = fmaxf(v1[e], 0.f); v0[e] = a * a; v1[e] = b * b; } }
                    u32x4 w; w.x = cvt_pk_bf16(v0[0], v0[1]); w.y = cvt_pk_bf16(v0[2], v0[3]); w.z = cvt_pk_bf16(v1[0], v1[1]); w.w = cvt_pk_bf16(v1[2], v1[3]);
                    *(u32x4*)(rowp + bj * HALF) = w; } }
    }
};
struct EpiResid {
    static constexpr bool PERM = true;
    const float* Xin; bf16_t* HB; int ldc; float* ss; int zrows;
    DI void operator()(const f32x4 (&acc)[2][2][4][2], const Unit& u, int wr, int wc, int fr, int fq) const {
        const int row0 = u.z * zrows + u.pm * BM + wr * 64 + fr; const int col0 = u.pn * BM + wc * 32 + 8 * fq;
#pragma unroll
        for (int ai = 0; ai < 2; ++ai)
#pragma unroll
            for (int m = 0; m < 4; ++m) { const int row = row0 + ai * HALF + m * 16; const size_t off = (size_t)row * ldc + col0; float s = 0.f;
#pragma unroll
                for (int bj = 0; bj < 2; ++bj) { const size_t o2 = off + bj * HALF; f32x4 p0, p1;
                    if (Xin) { p0 = *(const f32x4*)(Xin + o2); p1 = *(const f32x4*)(Xin + o2 + 4); }
                    else { const u32x4 h = *(const u32x4*)(HB + o2);
                        p0 = (f32x4){__uint_as_float(h.x << 16), __uint_as_float(h.x & 0xffff0000u), __uint_as_float(h.y << 16), __uint_as_float(h.y & 0xffff0000u)};
                        p1 = (f32x4){__uint_as_float(h.z << 16), __uint_as_float(h.z & 0xffff0000u), __uint_as_float(h.w << 16), __uint_as_float(h.w & 0xffff0000u)}; }
                    const f32x4 v0 = p0 + acc[ai][bj][m][0], v1 = p1 + acc[ai][bj][m][1];
                    s += ((v0[0] * v0[0] + v0[1] * v0[1]) + (v0[2] * v0[2] + v0[3] * v0[3])) + ((v1[0] * v1[0] + v1[1] * v1[1]) + (v1[2] * v1[2] + v1[3] * v1[3]));
                    u32x4 w; w.x = cvt_pk_bf16(v0[0], v0[1]); w.y = cvt_pk_bf16(v0[2], v0[3]); w.z = cvt_pk_bf16(v1[0], v1[1]); w.w = cvt_pk_bf16(v1[2], v1[3]);
                    *(u32x4*)(HB + o2) = w; }
                s += __shfl_xor(s, 16); s += __shfl_xor(s, 32);
                if (fq == 0) ss[(size_t)row * 32 + u.pn * 4 + wc] = s; }
    }
};
template <class ZO> struct EpiSoftmax {
    static constexpr bool PERM = false;
    bf16_t* P; int ldc; float scale2; const float* ss; int zrows;
    DI void operator()(const f32x4 (&acc)[2][2][4][2], const Unit& u, int wr, int wc, int fr, int fq) const {
        LAS float* TM = (LAS float*)(131072); LAS float* TS = TM + 1024;
        f32x4 v[2][4][2][2]; float mx[2][4];
#pragma unroll
        for (int ai = 0; ai < 2; ++ai)
#pragma unroll
            for (int m = 0; m < 4; ++m) { float t = -3.0e38f;
                const float rs = scale2 / sqrtf(row_ss(ss, u.z * zrows + u.pm * BM + ai * HALF + wr * 64 + m * 16 + fr, fq) * (1.f / 2048.f) + 1e-6f);
#pragma unroll
                for (int bj = 0; bj < 2; ++bj)
#pragma unroll
                    for (int n = 0; n < 2; ++n) { const f32x4 x = acc[ai][bj][m][n] * rs; v[ai][m][bj][n] = x; t = fmaxf(t, fmaxf(fmaxf(x[0], x[1]), fmaxf(x[2], x[3]))); }
                t = fmaxf(t, __shfl_xor(t, 16)); t = fmaxf(t, __shfl_xor(t, 32));
                if (fq == 0) TM[(ai * HALF + wr * 64 + m * 16 + fr) * 4 + wc] = t; }
        asm volatile("s_waitcnt lgkmcnt(0)" ::: "memory"); __builtin_amdgcn_s_barrier(); asm volatile("" ::: "memory");
#pragma unroll
        for (int ai = 0; ai < 2; ++ai)
#pragma unroll
            for (int m = 0; m < 4; ++m) { const f32x4 t4 = *(const LAS f32x4*)(TM + (ai * HALF + wr * 64 + m * 16 + fr) * 4);
                const float rm = fmaxf(fmaxf(t4[0], t4[1]), fmaxf(t4[2], t4[3])); float s = 0.f;
#pragma unroll
                for (int bj = 0; bj < 2; ++bj)
#pragma unroll
                    for (int n = 0; n < 2; ++n) { f32x4 x = v[ai][m][bj][n];
#pragma unroll
                        for (int e = 0; e < 4; ++e) x[e] = __builtin_amdgcn_exp2f(x[e] - rm);
                        v[ai][m][bj][n] = x; s += (x[0] + x[1]) + (x[2] + x[3]); }
                s += __shfl_xor(s, 16); s += __shfl_xor(s, 32);
                if (fq == 0) TS[(ai * HALF + wr * 64 + m * 16 + fr) * 4 + wc] = s; }
        asm volatile("s_waitcnt lgkmcnt(0)" ::: "memory"); __builtin_amdgcn_s_barrier(); asm volatile("" ::: "memory");
        const int row0 = u.pm * BM + wr * 64 + fr; const int col0 = u.pn * BM + wc * 32 + 4 * fq;
        bf16_t* base = P + ZO::off(u.z);
#pragma unroll
        for (int ai = 0; ai < 2; ++ai)
#pragma unroll
            for (int m = 0; m < 4; ++m) { const f32x4 s4 = *(const LAS f32x4*)(TS + (ai * HALF + wr * 64 + m * 16 + fr) * 4);
                const float inv = 1.0f / ((s4[0] + s4[1]) + (s4[2] + s4[3])); bf16_t* rowp = base + (size_t)(row0 + ai * HALF + m * 16) * ldc + col0;
#pragma unroll
                for (int bj = 0; bj < 2; ++bj)
#pragma unroll
                    for (int n = 0; n < 2; ++n) { const f32x4 x = v[ai][m][bj][n] * inv; typedef unsigned u32x2_t __attribute__((ext_vector_type(2)));
                        u32x2_t w; w.x = cvt_pk_bf16(x[0], x[1]); w.y = cvt_pk_bf16(x[2], x[3]); *(u32x2_t*)(rowp + bj * HALF + n * 16) = w; } }
        asm volatile("s_waitcnt lgkmcnt(0)" ::: "memory"); __builtin_amdgcn_s_barrier(); asm volatile("" ::: "memory");
    }
};

template <class Epi, int K, int LDA, int LDB, class ZA, class ZB>
DI void gemm_phase(LAS unsigned char* lds, const bf16_t* gA, const bf16_t* gBt, const Order& S, const Epi& E) {
    const int tid = threadIdx.x, wid = __builtin_amdgcn_readfirstlane(tid >> 6), lane = tid & 63, wr = wid >> 2, wc = wid & 3, fr = lane & 15, fq = lane >> 4;
    constexpr int nt = K / BK;
    unsigned voffA[2], voffB[2];
#pragma unroll
    for (int i = 0; i < 2; ++i) { int R, C; stage_rc(tid * 16 + i * 8192, R, C); const int Rb = Epi::PERM ? ((R & ~31) + perm32(R & 31)) : R;
        voffA[i] = (unsigned)(R * LDA + C) * 2u; voffB[i] = (unsigned)(Rb * LDB + C) * 2u; }
    constexpr size_t kstep = (size_t)(BK * 2);
    constexpr size_t hstepA = (size_t)HALF * LDA * 2, hstepB = (size_t)HALF * LDB * 2;
    constexpr size_t tstepA = 2 * hstepA, tstepB = 2 * hstepB;
    const unsigned ldsw = (unsigned)wid * 1024u;
    const int aoff = lds_byte(wr * 64 + fr, fq * 8), boff = lds_byte(wc * 32 + fr, fq * 8);
#define PG8_SA(b, h) (((b) * 2 + (h)) * HTB)
#define PG8_SB(b, h) ((4 + (b) * 2 + (h)) * HTB)
#define PG8_STAGE(bufoff, gbase, voff) do { _Pragma("unroll") for (int _i = 0; _i < 2; ++_i) \
        __builtin_amdgcn_global_load_lds((const unsigned*)((const char*)(gbase) + (voff)[_i]), (LAS unsigned*)(lds + (bufoff) + ldsw + _i * 8192), 16, 0, 0); } while (0)
#define PG8_LDA(dst, b, h) do { _Pragma("unroll") for (int m = 0; m < 4; ++m) _Pragma("unroll") for (int k = 0; k < 2; ++k) dst[m][k] = *(const LAS bf16x8*)(lds + PG8_SA(b, h) + aoff + m * 2048 + k * 1024); } while (0)
#define PG8_LDB(dst, b, h) do { _Pragma("unroll") for (int n = 0; n < 2; ++n) _Pragma("unroll") for (int k = 0; k < 2; ++k) dst[n][k] = *(const LAS bf16x8*)(lds + PG8_SB(b, h) + boff + n * 2048 + k * 1024); } while (0)
#define PG8_MMA(ai, bj, At, Bt) do { __builtin_amdgcn_s_setprio(1); _Pragma("unroll") for (int m = 0; m < 4; ++m) _Pragma("unroll") for (int n = 0; n < 2; ++n) _Pragma("unroll") for (int k = 0; k < 2; ++k) \
        acc[ai][bj][m][n] = __builtin_amdgcn_mfma_f32_16x16x32_bf16(Bt[n][k], At[m][k], acc[ai][bj][m][n], 0, 0, 0); __builtin_amdgcn_s_setprio(0); } while (0)
#define PG8_WAIT_V(n) asm volatile("s_waitcnt vmcnt(" #n ")" ::: "memory")
#define PG8_WAIT_L(n) asm volatile("s_waitcnt lgkmcnt(" #n ")" ::: "memory")
#define PG8_BAR __builtin_amdgcn_s_barrier()
#define PG8_SCHED __builtin_amdgcn_sched_barrier(0)
    Unit cur, nxt; int ui = 0;
    if (!S.next(0, cur)) return;
    f32x4 acc[2][2][4][2];
#pragma unroll
    for (int a = 0; a < 2; ++a)
#pragma unroll
        for (int b = 0; b < 2; ++b)
#pragma unroll
            for (int m = 0; m < 4; ++m)
#pragma unroll
                for (int n = 0; n < 2; ++n) acc[a][b][m][n] = (f32x4){0.f, 0.f, 0.f, 0.f};
    bf16x8 At[4][2], B0[2][2], B1[2][2];
    const char* cA = (const char*)gA + (size_t)ZA::off(cur.z) * 2 + (size_t)cur.pm * tstepA; const char* cB = (const char*)gBt + (size_t)ZB::off(cur.z) * 2 + (size_t)cur.pn * tstepB;
    PG8_STAGE(PG8_SB(0, 0), cB, voffB); PG8_STAGE(PG8_SB(0, 1), cB + hstepB, voffB); PG8_STAGE(PG8_SA(0, 0), cA, voffA); PG8_STAGE(PG8_SA(0, 1), cA + hstepA, voffA);
    if (wr == 1) PG8_BAR;
    PG8_WAIT_V(2); PG8_BAR;
    PG8_STAGE(PG8_SB(1, 0), cB + kstep, voffB); PG8_STAGE(PG8_SA(1, 0), cA + kstep, voffA); PG8_STAGE(PG8_SB(1, 1), cB + hstepB + kstep, voffB);
    PG8_WAIT_V(6); PG8_BAR;
    for (;;) {
        const bool has_next = S.next(ui + 1, nxt);
        const char* nA = has_next ? (const char*)gA + (size_t)ZA::off(nxt.z) * 2 + (size_t)nxt.pm * tstepA : cA; const char* nB = has_next ? (const char*)gBt + (size_t)ZB::off(nxt.z) * 2 + (size_t)nxt.pn * tstepB : cB;
#pragma unroll 1
        for (int t = 0; t < nt; t += 2) {
            const bool last = (t == nt - 2);
            const char* a1 = cA + (size_t)(t + 1) * kstep;
            const char* a2 = last ? nA : cA + (size_t)(t + 2) * kstep; const char* b2 = last ? nB : cB + (size_t)(t + 2) * kstep;
            const char* a3 = a2 + kstep; const char* b3 = b2 + kstep;
            PG8_LDB(B0, 0, 0); PG8_LDB(B1, 0, 1); PG8_SCHED; PG8_LDA(At, 0, 0); PG8_STAGE(PG8_SA(1, 1), a1 + hstepA, voffA);
            PG8_WAIT_V(8); PG8_WAIT_L(0); PG8_BAR; PG8_MMA(0, 0, At, B0); PG8_MMA(0, 1, At, B1); PG8_BAR; PG8_SCHED;
            PG8_LDA(At, 0, 1); PG8_STAGE(PG8_SB(0, 0), b2, voffB); PG8_STAGE(PG8_SB(0, 1), b2 + hstepB, voffB); PG8_STAGE(PG8_SA(0, 0), a2, voffA);
            PG8_WAIT_V(8); PG8_WAIT_L(0); PG8_BAR; PG8_MMA(1, 0, At, B0); PG8_MMA(1, 1, At, B1); PG8_BAR; PG8_SCHED;
            PG8_LDB(B0, 1, 0); PG8_LDB(B1, 1, 1); PG8_SCHED; PG8_LDA(At, 1, 0); PG8_STAGE(PG8_SA(0, 1), a2 + hstepA, voffA);
            PG8_WAIT_V(8); PG8_WAIT_L(0); PG8_BAR; PG8_MMA(0, 0, At, B0); PG8_MMA(0, 1, At, B1); PG8_BAR; PG8_SCHED;
            PG8_LDA(At, 1, 1); PG8_STAGE(PG8_SB(1, 0), b3, voffB); PG8_STAGE(PG8_SB(1, 1), b3 + hstepB, voffB); PG8_STAGE(PG8_SA(1, 0), a3, voffA);
            PG8_WAIT_V(8); PG8_WAIT_L(0); PG8_BAR; PG8_MMA(1, 0, At, B0); PG8_MMA(1, 1, At, B1); PG8_BAR; PG8_SCHED;
        }
        if (wr == 0) PG8_BAR;
        E(acc, cur, wr, wc, fr, fq);
        if (!has_next) break;
#pragma unroll
        for (int a = 0; a < 2; ++a)
#pragma unroll
            for (int b = 0; b < 2; ++b)
#pragma unroll
                for (int m = 0; m < 4; ++m)
#pragma unroll
                    for (int n = 0; n < 2; ++n) acc[a][b][m][n] = (f32x4){0.f, 0.f, 0.f, 0.f};
        cur = nxt; cA = nA; cB = nB; ++ui;
        if (wr == 1) PG8_BAR;
    }
    PG8_WAIT_V(0);
    PG8_BAR;
#undef PG8_SA
#undef PG8_SB
#undef PG8_STAGE
#undef PG8_LDA
#undef PG8_LDB
#undef PG8_MMA
#undef PG8_WAIT_V
#undef PG8_WAIT_L
#undef PG8_BAR
#undef PG8_SCHED
}
}

typedef unsigned short bf16_t;
typedef float f32x4 __attribute__((ext_vector_type(4)));
typedef float f32x16 __attribute__((ext_vector_type(16)));
typedef short bf16x8 __attribute__((ext_vector_type(8)));
typedef short s16x4 __attribute__((ext_vector_type(4)));
typedef unsigned u32x4 __attribute__((ext_vector_type(4)));
typedef unsigned u32x2 __attribute__((ext_vector_type(2)));
typedef int i32x4 __attribute__((ext_vector_type(4)));

DI unsigned f2bf(float f) { unsigned u = __builtin_bit_cast(unsigned, f); return (u + 0x7fffu + ((u >> 16) & 1u)) >> 16; }
DI unsigned pk2(float lo, float hi) { return f2bf(lo) | (f2bf(hi) << 16); }
DI float wave_sum(float v) {
#pragma unroll
    for (int o = 1; o < 64; o <<= 1) v += __shfl_xor(v, o);
    return v;
}
DI int wave_maxi(int v) {
#pragma unroll
    for (int o = 1; o < 64; o <<= 1) { const int w = __shfl_xor(v, o); v = w > v ? w : v; }
    return v;
}
DI int wave_mini(int v) {
#pragma unroll
    for (int o = 1; o < 64; o <<= 1) { const int w = __shfl_xor(v, o); v = w < v ? w : v; }
    return v;
}

DI void transpose_item(const float* W, int K, int N, bf16_t* WT, LAS float* scr, int item, int lane, const float* g) {
    const int nblk = N / 64, kb = item / nblk, nb = item % nblk, k0 = 64 * kb, n0 = 64 * nb;
    const int c4 = (lane & 15) * 4;
#pragma unroll 8
    for (int i = 0; i < 16; ++i) { const int kk = 4 * i + (lane >> 4); const f32x4 v = *(const f32x4*)(W + (size_t)(k0 + kk) * N + n0 + c4);
        LAS float* d = scr + kk * 65 + c4; d[0] = v.x; d[1] = v.y; d[2] = v.z; d[3] = v.w; }
    asm volatile("s_waitcnt lgkmcnt(0)" ::: "memory");
    const int c = lane & 7;
    f32x4 g0 = {1.f, 1.f, 1.f, 1.f}, g1 = {1.f, 1.f, 1.f, 1.f};
    if (g) { g0 = *(const f32x4*)(g + k0 + 8 * c); g1 = *(const f32x4*)(g + k0 + 8 * c + 4); }
#pragma unroll
    for (int j = 0; j < 8; ++j) { const int n = (lane >> 3) + 8 * j; const LAS float* s = scr + (8 * c) * 65 + n;
        u32x4 o; o.x = pk2(s[0 * 65] * g0.x, s[1 * 65] * g0.y); o.y = pk2(s[2 * 65] * g0.z, s[3 * 65] * g0.w); o.z = pk2(s[4 * 65] * g1.x, s[5 * 65] * g1.y); o.w = pk2(s[6 * 65] * g1.z, s[7 * 65] * g1.w);
        *(u32x4*)(WT + (size_t)(n0 + n) * K + k0 + 8 * c) = o; }
    asm volatile("s_waitcnt lgkmcnt(0)" ::: "memory");
}
DI void prep_row(const float* xrow, bf16_t* orow, float* ss, int lane) {
    const f32x4* xr = (const f32x4*)xrow + lane; f32x4 v[8]; float s = 0.f;
#pragma unroll
    for (int j = 0; j < 8; ++j) { v[j] = xr[64 * j]; s += (v[j].x * v[j].x + v[j].y * v[j].y) + (v[j].z * v[j].z + v[j].w * v[j].w); }
    s = wave_sum(s);
    u32x2* o8 = (u32x2*)orow + lane;
#pragma unroll
    for (int j = 0; j < 8; ++j) { u32x2 w; w.x = pk2(v[j].x, v[j].y); w.y = pk2(v[j].z, v[j].w); o8[64 * j] = w; }
    if (lane < 32) ss[lane] = (lane == 0) ? s : 0.f;
}
DI void scale_row_out(const bf16_t* hrow, float* orow, const float* g, float ssv, int lane) {
    const u32x2* hr = (const u32x2*)hrow + lane; f32x4* xr = (f32x4*)orow + lane; const f32x4* gr = (const f32x4*)g + lane; const float rstd = 1.0f / sqrtf(ssv * (1.f / DM) + EPS);
#pragma unroll
    for (int j = 0; j < 8; ++j) { const u32x2 h = hr[64 * j]; const f32x4 v = {__uint_as_float(h.x << 16), __uint_as_float(h.x & 0xffff0000u), __uint_as_float(h.y << 16), __uint_as_float(h.y & 0xffff0000u)};
        xr[64 * j] = v * rstd * gr[64 * j]; }
}
DI void scaled_row_bf16(const float* xrow, float sc, bf16_t* orow, int lane) {
    const f32x4* xr = (const f32x4*)xrow + lane; u32x2* o8 = (u32x2*)orow + lane;
#pragma unroll
    for (int j = 0; j < 8; ++j) { const f32x4 v = xr[64 * j] * sc; u32x2 w; w.x = pk2(v.x, v.y); w.y = pk2(v.z, v.w); o8[64 * j] = w; }
}
DI void rms_row_bf16(const float* xrow, const float* g, bf16_t* orow, float* copy, int lane) {
    const f32x4* xr = (const f32x4*)xrow + lane; f32x4 v[8]; float s = 0.f;
#pragma unroll
    for (int j = 0; j < 8; ++j) { v[j] = xr[64 * j]; s += (v[j].x * v[j].x + v[j].y * v[j].y) + (v[j].z * v[j].z + v[j].w * v[j].w); }
    const float rstd = 1.0f / sqrtf(wave_sum(s) * (1.f / DM) + EPS);
    const f32x4* gr = (const f32x4*)g + lane; u32x2* o8 = (u32x2*)orow + lane;
#pragma unroll
    for (int j = 0; j < 8; ++j) { const f32x4 gg = gr[64 * j]; u32x2 w; w.x = pk2(v[j].x * rstd * gg.x, v[j].y * rstd * gg.y); w.y = pk2(v[j].z * rstd * gg.z, v[j].w * rstd * gg.w); o8[64 * j] = w; }
    if (copy) { f32x4* c = (f32x4*)copy + lane;
#pragma unroll
        for (int j = 0; j < 8; ++j) c[64 * j] = v[j]; }
}

namespace att {
constexpr int KROW = 272, VROW = 320;
constexpr int L_K = 0, L_V = 17408, L_POS = 58368, L_SK = 58624, L_FLAG = 58880;
constexpr float NEGBIG = -1e30f;
constexpr int D_K = 0, D_V = 34816, D_POS = 75776, D_SK = 76288, D_X = 0;

DI unsigned cvtpk(float lo, float hi) { typedef float f2 __attribute__((ext_vector_type(2))); typedef __bf16 b2 __attribute__((ext_vector_type(2))); f2 v = {lo, hi}; b2 b = __builtin_convertvector(v, b2); return __builtin_bit_cast(unsigned, b); }
DI s16x4 vtr(const LAS char* p) { typedef short v4i16_t __attribute__((ext_vector_type(4))); return __builtin_bit_cast(s16x4, __builtin_amdgcn_ds_read_tr16_b64_v4i16((LAS v4i16_t*)p)); }
DI float hmax(float m) { auto rr = __builtin_amdgcn_permlane32_swap(__float_as_uint(m), __float_as_uint(m), false, false); return fmaxf(__uint_as_float(rr[0]), __uint_as_float(rr[1])); }
DI float hsum(float m) { auto rr = __builtin_amdgcn_permlane32_swap(__float_as_uint(m), __float_as_uint(m), false, false); return __uint_as_float(rr[0]) + __uint_as_float(rr[1]); }
DI float hpartner(float x, int hl) { auto rr = __builtin_amdgcn_permlane32_swap(__float_as_uint(x), __float_as_uint(x), false, false); return __uint_as_float(hl ? rr[0] : rr[1]); }
DI bf16x8 pack8(const f32x16& x, int s) {
    u32x4 p; p.x = cvtpk(x[8 * s], x[8 * s + 1]); p.y = cvtpk(x[8 * s + 2], x[8 * s + 3]); p.z = cvtpk(x[8 * s + 4], x[8 * s + 5]); p.w = cvtpk(x[8 * s + 6], x[8 * s + 7]);
    return __builtin_bit_cast(bf16x8, p);
}
#define MFMA32(a, b, c) __builtin_amdgcn_mfma_f32_32x32x16_bf16((a), (b), (c), 0, 0, 0)

struct Stage { u32x4 k[2], v[2]; int pos; };
DI void stage_load(Stage& st, const bf16_t* kbase, const bf16_t* vbase, const int* posb, int kt, int tid) {
    const unsigned toff = (unsigned)(((tid >> 4) * INC + (tid & 15) * 8) * 2);
    const char* kb_ = (const char*)kbase + (size_t)kt * (64 * INC * 2); const char* vb_ = (const char*)vbase + (size_t)kt * (64 * INC * 2);
    st.k[0] = *(const u32x4*)(kb_ + toff); st.k[1] = *(const u32x4*)(kb_ + 32 * INC * 2 + toff);
    st.v[0] = *(const u32x4*)(vb_ + toff); st.v[1] = *(const u32x4*)(vb_ + 32 * INC * 2 + toff);
    st.pos = (tid < 64) ? posb[kt * 64 + tid] : 0;
}
DI void stage_store(const Stage& st, LAS char* lds, int tid, float slope2, int pos_ref, int voff) {
#pragma unroll
    for (int i = 0; i < 2; ++i) { const int c = tid + 512 * i, row = c >> 4, ch = c & 15;
        *(LAS u32x4*)(lds + L_K + row * KROW + ch * 16) = st.k[i]; *(LAS u32x4*)(lds + voff + row * VROW + ch * 16) = st.v[i]; }
    if (tid < 64) { *(LAS int*)(lds + L_POS + tid * 4) = st.pos; *(LAS float*)(lds + L_SK + tid * 4) = slope2 * (float)(st.pos - pos_ref); }
}
struct Stage2 { u32x4 k[4], v[4]; int pos; };
DI void stage2_load(Stage2& st, const bf16_t* kbase, const bf16_t* vbase, const int* posb, int kt, int tid) {
    const unsigned toff = (unsigned)(((tid >> 4) * INC + (tid & 15) * 8) * 2);
    const char* kb_ = (const char*)kbase + (size_t)kt * (128 * INC * 2); const char* vb_ = (const char*)vbase + (size_t)kt * (128 * INC * 2);
#pragma unroll
    for (int i = 0; i < 4; ++i) { st.k[i] = *(const u32x4*)(kb_ + (size_t)i * (32 * INC * 2) + toff); st.v[i] = *(const u32x4*)(vb_ + (size_t)i * (32 * INC * 2) + toff); }
    st.pos = (tid < 128) ? posb[kt * 128 + tid] : 0;
}
DI void stage2_store(const Stage2& st, LAS char* lds, int tid, float slope2, int pos_ref) {
#pragma unroll
    for (int i = 0; i < 4; ++i) { const int row = (tid >> 4) + 32 * i, ch = tid & 15;
        *(LAS u32x4*)(lds + D_K + row * KROW + ch * 16) = st.k[i]; *(LAS u32x4*)(lds + D_V + row * VROW + ch * 16) = st.v[i]; }
    if (tid < 128) { *(LAS int*)(lds + D_POS + tid * 4) = st.pos; *(LAS float*)(lds + D_SK + tid * 4) = slope2 * (float)(st.pos - pos_ref); }
}
DI bf16x8 scale_frag(const bf16x8 v, float sc) {
    const u32x4 u = __builtin_bit_cast(u32x4, v); u32x4 o;
#pragma unroll
    for (int i = 0; i < 4; ++i) { const float lo = __uint_as_float(u[i] << 16) * sc, hi = __uint_as_float(u[i] & 0xffff0000u) * sc; o[i] = cvtpk(lo, hi); }
    return __builtin_bit_cast(bf16x8, o);
}
DI void pv_acc(f32x16 (&O)[4], const LAS char* vb, const bf16x8 pb00, const bf16x8 pb01, const bf16x8 pb10, const bf16x8 pb11) {
#pragma unroll
    for (int d = 0; d < 4; ++d) {
#pragma unroll
        for (int ss = 0; ss < 4; ++ss) {
            const s16x4 lo = vtr(vb + (ss * 16) * VROW + d * 64), hi = vtr(vb + (ss * 16 + 8) * VROW + d * 64);
            const bf16x8 a = {lo[0], lo[1], lo[2], lo[3], hi[0], hi[1], hi[2], hi[3]};
            const bf16x8 pb = ss == 0 ? pb00 : ss == 1 ? pb01 : ss == 2 ? pb10 : pb11;
            O[d] = MFMA32(a, pb, O[d]);
        }
    }
}

DI void store_rows(LAS char* stg, const f32x16 (&O)[4], float rstd, const float* subg, int hl_, int r32_, int lane_, bf16_t* obase) {
    int lane = lane_; asm volatile("" : "+v"(lane));
    const int hl = lane >> 5, r32 = lane & 31; (void)hl_; (void)r32_;
#pragma unroll
    for (int d = 0; d < 4; ++d)
#pragma unroll
        for (int j = 0; j < 4; ++j) { const int dc = d * 32 + 8 * j + 4 * hl; const f32x4 g4 = *(const f32x4*)(subg + dc);
            u32x2 w; w.x = cvtpk(O[d][4 * j] * rstd * g4.x, O[d][4 * j + 1] * rstd * g4.y); w.y = cvtpk(O[d][4 * j + 2] * rstd * g4.z, O[d][4 * j + 3] * rstd * g4.w);
            *(LAS u32x2*)(stg + r32 * 272 + dc * 2) = w; }
    asm volatile("s_waitcnt lgkmcnt(0)" ::: "memory");
    unsigned voff = (unsigned)(((lane >> 4) * DM + (lane & 15) * 8) * 2);
    asm volatile("" : "+v"(voff));
#pragma unroll
    for (int i = 0; i < 8; ++i) { const u32x4 v = *(const LAS u32x4*)(stg + (i * 4 + (lane >> 4)) * 272 + (lane & 15) * 16);
        *(u32x4*)((char*)obase + (size_t)i * (4 * DM * 2) + voff) = v; }
}

DI void diff_unit(LAS char* lds, const bf16_t* qkv, bf16_t* omix, const int* pos, const int* pmn, const int* pmx, int b, int h, int qb, float lam, float oml, const float* subg, int tid) {
    const int lane = tid & 63, wid = __builtin_amdgcn_readfirstlane(tid >> 6), r32 = lane & 31, hl = lane >> 5, rg = wid >> 1, mp = wid & 1;
    const int q0 = qb * 128, qi = q0 + rg * 32 + r32; const size_t tok = (size_t)b * SEQ + qi;
    const int posq = pos[tok];
    const int* pmnb = pmn + b * 32; const int* pmxb = pmx + b * 32; const int* posb = pos + b * SEQ;
    const int qmax = max(pmxb[q0 >> 6], pmxb[(q0 >> 6) + 1]);
    const int wqmin = pmnb[(q0 + rg * 32) >> 6];
    const int pos_ref = posb[q0];
    const float slope2 = exp2f(-(float)(h + 1)) * LOG2E, scale2 = 0.125f * LOG2E;
    bf16x8 qf[4];
#pragma unroll
    for (int s = 0; s < 4; ++s) qf[s] = *(const bf16x8*)(qkv + tok * INC + C_DQ + h * 128 + mp * 64 + 16 * s + 8 * hl);
    const bf16_t* kbase = qkv + (size_t)b * SEQ * INC + C_DK + h * 128; const bf16_t* vbase = qkv + (size_t)b * SEQ * INC + C_DV + h * 128;
    float m = -3.0e38f, lsum = 0.f; f32x16 O[4];
#pragma unroll
    for (int d = 0; d < 4; ++d)
#pragma unroll
        for (int r = 0; r < 16; ++r) O[d][r] = 0.f;
    const LAS char* kb0 = lds + D_K + r32 * KROW + mp * 128 + hl * 16;
    const LAS char* vb0 = lds + D_V + (4 * hl + ((lane & 15) >> 2)) * VROW + ((lane >> 4) & 1) * 32 + (lane & 3) * 8;
    const LAS int* pl0 = (const LAS int*)(lds + D_POS);
    const LAS float* skl0 = (const LAS float*)(lds + D_SK);
#define DIFF_FULL(NM0_, NM1_) do { \
        f32x16 p0, p1, p2, p3; \
        _Pragma("unroll") \
        for (int j = 0; j < 4; ++j) { const f32x4 c0 = *(const LAS f32x4*)(skl0 + 8 * j + 4 * hl), c1 = *(const LAS f32x4*)(skl0 + 32 + 8 * j + 4 * hl), \
                                                  c2 = *(const LAS f32x4*)(skl0 + 64 + 8 * j + 4 * hl), c3 = *(const LAS f32x4*)(skl0 + 96 + 8 * j + 4 * hl); \
        _Pragma("unroll") \
            for (int i = 0; i < 4; ++i) { p0[4 * j + i] = c0[i]; p1[4 * j + i] = c1[i]; p2[4 * j + i] = c2[i]; p3[4 * j + i] = c3[i]; } } \
        _Pragma("unroll") \
        for (int s = 0; s < 4; ++s) { \
            const bf16x8 a0 = *(const LAS bf16x8*)(kb0 + s * 32), a1 = *(const LAS bf16x8*)(kb0 + 32 * KROW + s * 32), \
                         a2 = *(const LAS bf16x8*)(kb0 + 64 * KROW + s * 32), a3 = *(const LAS bf16x8*)(kb0 + 96 * KROW + s * 32); \
            p0 = MFMA32(a0, qf[s], p0); p1 = MFMA32(a1, qf[s], p1); p2 = MFMA32(a2, qf[s], p2); p3 = MFMA32(a3, qf[s], p3); } \
        if (NM0_) { \
        _Pragma("unroll") \
            for (int j = 0; j < 4; ++j) { const i32x4 k0 = *(const LAS i32x4*)(pl0 + 8 * j + 4 * hl), k1 = *(const LAS i32x4*)(pl0 + 32 + 8 * j + 4 * hl); \
        _Pragma("unroll") \
                for (int i = 0; i < 4; ++i) { const int r = 4 * j + i; p0[r] = k0[i] <= posq ? p0[r] : NEGBIG; p1[r] = k1[i] <= posq ? p1[r] : NEGBIG; } } \
        } \
        if (NM1_) { \
        _Pragma("unroll") \
            for (int j = 0; j < 4; ++j) { const i32x4 k2 = *(const LAS i32x4*)(pl0 + 64 + 8 * j + 4 * hl), k3 = *(const LAS i32x4*)(pl0 + 96 + 8 * j + 4 * hl); \
        _Pragma("unroll") \
                for (int i = 0; i < 4; ++i) { const int r = 4 * j + i; p2[r] = k2[i] <= posq ? p2[r] : NEGBIG; p3[r] = k3[i] <= posq ? p3[r] : NEGBIG; } } \
        } \
        float mx = fmaxf(fmaxf(p0[0], p1[0]), fmaxf(p2[0], p3[0])); \
        _Pragma("unroll") \
        for (int r = 1; r < 16; ++r) mx = fmaxf(mx, fmaxf(fmaxf(p0[r], p1[r]), fmaxf(p2[r], p3[r]))); \
        mx = hmax(mx); \
        if (__any(mx > m + 8.0f)) { const float mnew = fmaxf(m, mx); const float alpha = __builtin_amdgcn_exp2f(m - mnew); lsum *= alpha; m = mnew; \
        _Pragma("unroll") \
            for (int d = 0; d < 4; ++d) \
        _Pragma("unroll") \
                for (int r = 0; r < 16; ++r) O[d][r] *= alpha; } \
        float ts = 0.f; \
        _Pragma("unroll") \
        for (int r = 0; r < 16; ++r) { p0[r] = __builtin_amdgcn_exp2f(p0[r] - m); p1[r] = __builtin_amdgcn_exp2f(p1[r] - m); ts += p0[r] + p1[r]; } \
        { const bf16x8 pb00 = pack8(p0, 0), pb01 = pack8(p0, 1), pb10 = pack8(p1, 0), pb11 = pack8(p1, 1); \
          pv_acc(O, vb0, pb00, pb01, pb10, pb11); } \
        _Pragma("unroll") \
        for (int r = 0; r < 16; ++r) { p2[r] = __builtin_amdgcn_exp2f(p2[r] - m); p3[r] = __builtin_amdgcn_exp2f(p3[r] - m); ts += p2[r] + p3[r]; } \
        lsum += ts; \
        { const bf16x8 pb00 = pack8(p2, 0), pb01 = pack8(p2, 1), pb10 = pack8(p3, 0), pb11 = pack8(p3, 1); \
          pv_acc(O, vb0 + 64 * VROW, pb00, pb01, pb10, pb11); } \
    } while (0)
#define DIFF_SKIP(n_) (min(pmnb[2 * (n_)], pmnb[2 * (n_) + 1]) > qmax)
#define DIFF_NEXT(k_) ({ int n_ = (k_) + 1; while (n_ < 16 && DIFF_SKIP(n_)) ++n_; n_ < 16 ? n_ : -1; })
    int ta = DIFF_NEXT(-1); Stage2 st;
    if (ta >= 0) stage2_load(st, kbase, vbase, posb, ta, tid);
    while (ta >= 0) {
        __syncthreads();
        stage2_store(st, lds, tid, slope2, pos_ref);
        __syncthreads();
        const int tn = DIFF_NEXT(ta);
        if (tn >= 0) stage2_load(st, kbase, vbase, posb, tn, tid);
        const bool nm0 = pmxb[2 * ta] > wqmin, nm1 = pmxb[2 * ta + 1] > wqmin;
        DIFF_FULL(nm0, nm1);
        ta = tn;
    }
#undef DIFF_FULL
#undef DIFF_SKIP
#undef DIFF_NEXT
    __syncthreads();
    const float inv = 1.0f / hsum(lsum);
    LAS float* X = (LAS float*)(lds + D_X) + rg * 4096;
    if (mp == 1) { const float f = lam * inv;
#pragma unroll
        for (int d = 0; d < 4; ++d)
#pragma unroll
            for (int r = 0; r < 16; ++r) X[(d * 16 + r) * 64 + lane] = O[d][r] * f; }
    __syncthreads();
    if (mp == 0) {
        float ss = 0.f;
#pragma unroll
        for (int d = 0; d < 4; ++d)
#pragma unroll
            for (int r = 0; r < 16; ++r) { const float o = O[d][r] * inv - X[(d * 16 + r) * 64 + lane]; O[d][r] = o; ss += o * o; }
        ss = hsum(ss);
        const float rstd = oml / sqrtf(ss * (1.f / 128.f) + EPS);
        store_rows(lds + 65536 + rg * 8704, O, rstd, subg, hl, r32, lane, omix + ((size_t)b * SEQ + q0 + rg * 32) * DM + h * 128);
    }
}

DI void sb_unit(LAS char* lds, const bf16_t* qkv, bf16_t* omix, const int* pos, const int* pmn, const int* pmx, int b, int h, int qb, const float* subg, int tid) {
    const int lane = tid & 63, wid = __builtin_amdgcn_readfirstlane(tid >> 6), r32 = lane & 31, hl = lane >> 5;
    const int q0 = qb * 256, qi = q0 + wid * 32 + r32; const size_t tok = (size_t)b * SEQ + qi;
    const int posq = pos[tok];
    const int* pmnb = pmn + b * 32; const int* posb = pos + b * SEQ;
    int qmaxu = pmx[b * 32 + (q0 >> 6)];
#pragma unroll
    for (int i = 1; i < 4; ++i) qmaxu = max(qmaxu, pmx[b * 32 + (q0 >> 6) + i]);
    const int wqmax = pmx[b * 32 + ((q0 + 32 * wid) >> 6)];
    const float scale = 0.08838834764831845f;
    bf16x8 qf[8];
#pragma unroll
    for (int s = 0; s < 8; ++s) qf[s] = *(const bf16x8*)(qkv + tok * INC + C_SQ + h * 128 + 16 * s + 8 * hl);
    const bf16_t* kbase = qkv + (size_t)b * SEQ * INC + C_SK + h * 128; const bf16_t* vbase = qkv + (size_t)b * SEQ * INC + C_SV + h * 128;
    float carry = 1.0f; f32x16 O[4];
#pragma unroll
    for (int d = 0; d < 4; ++d)
#pragma unroll
        for (int r = 0; r < 16; ++r) O[d][r] = 0.f;
    const LAS char* vb = lds + L_V + (4 * hl + ((lane & 15) >> 2)) * VROW + ((lane >> 4) & 1) * 32 + (lane & 3) * 8;
    const LAS int* pl = (const LAS int*)(lds + L_POS);
    LAS int* flags = (LAS int*)(lds + L_FLAG);
    if (lane == 0) flags[wid] = 0;
    bool wdone = false;
    int kt = 31; while (kt >= 0 && pmnb[kt] >= qmaxu) --kt;
    Stage st; if (kt >= 0) stage_load(st, kbase, vbase, posb, kt, tid);
    while (kt >= 0) {
        __syncthreads();
        int nd = 0;
#pragma unroll
        for (int w = 0; w < 8; ++w) nd += flags[w];
        if (nd == 8) break;
        stage_store(st, lds, tid, 0.f, 0, L_V);
        __syncthreads();
        int kn = kt - 1; while (kn >= 0 && pmnb[kn] >= qmaxu) --kn;
        if (kn >= 0) stage_load(st, kbase, vbase, posb, kn, tid);
        if (!wdone && pmnb[kt] < wqmax) {
            bf16x8 pbs[2][2];
#pragma unroll
            for (int sub = 1; sub >= 0; --sub) {
                const LAS char* kb = lds + L_K + (sub * 32 + r32) * KROW + hl * 16;
                f32x16 z;
#pragma unroll
                for (int r = 0; r < 16; ++r) z[r] = 0.f;
#pragma unroll
                for (int s = 0; s < 8; ++s) z = MFMA32(*(const LAS bf16x8*)(kb + s * 32), qf[s], z);
                float E[16], G[4], Gp[4];
#pragma unroll
                for (int j = 0; j < 4; ++j) { const i32x4 kp = *(const LAS i32x4*)(pl + sub * 32 + 8 * j + 4 * hl);
                    float kk[4];
#pragma unroll
                    for (int i = 0; i < 4; ++i) { const int r = 4 * j + i; const bool valid = kp[i] < posq;
                        const float e = __builtin_amdgcn_exp2f(-fmaxf(z[r], -120.f)); const float beta = __builtin_amdgcn_rcpf(1.0f + e);
                        kk[i] = valid ? e * beta : 1.0f; z[r] = valid ? beta : 0.f; }
                    E[4 * j + 3] = 1.0f; E[4 * j + 2] = kk[3]; E[4 * j + 1] = kk[3] * kk[2]; E[4 * j] = E[4 * j + 1] * kk[1]; G[j] = E[4 * j] * kk[0]; }
#pragma unroll
                for (int j = 0; j < 4; ++j) Gp[j] = hpartner(G[j], hl);
                const float T3 = G[3] * Gp[3], T2 = (G[2] * Gp[2]) * T3, T1 = (G[1] * Gp[1]) * T2, T0 = (G[0] * Gp[0]) * T1;
                float suf[4]; suf[0] = T1; suf[1] = T2; suf[2] = T3; suf[3] = 1.0f;
#pragma unroll
                for (int j = 0; j < 4; ++j) { if (hl == 0) suf[j] *= Gp[j]; suf[j] *= carry; }
#pragma unroll
                for (int r = 0; r < 16; ++r) z[r] = z[r] * (E[r] * suf[r >> 2]);
                carry *= T0;
                pbs[sub][0] = pack8(z, 0); pbs[sub][1] = pack8(z, 1);
            }
            pv_acc(O, vb, pbs[0][0], pbs[0][1], pbs[1][0], pbs[1][1]);
            wdone = __all(carry < 1e-36f);
            if (lane == 0) flags[wid] = wdone ? 1 : 0;
        }
        kt = kn;
    }
    __syncthreads();
    float ss = 0.f;
#pragma unroll
    for (int d = 0; d < 4; ++d)
#pragma unroll
        for (int r = 0; r < 16; ++r) ss += O[d][r] * O[d][r];
    ss = hsum(ss);
    const float rstd = 1.0f / sqrtf(ss * (1.f / 128.f) + EPS);
    store_rows(lds + 61440 + wid * 8704, O, rstd, subg, hl, r32, lane, omix + ((size_t)b * SEQ + q0 + wid * 32) * DM + 1024 + h * 128);
    __syncthreads();
}
}

constexpr int NWAVES = 8;
constexpr int LDS_BYTES = 147456;
constexpr int PH_PER_LAYER = 7, N_PHASES = 3 + NLAYER * PH_PER_LAYER + 1;
struct Args { const void* in[21]; float* out; unsigned char* ws; int ph_lo, ph_hi; };

DI const void* karg(int i) {
    const __attribute__((address_space(1))) char* p;
    asm volatile("s_load_dwordx2 %0, %1, %2\n\ts_waitcnt lgkmcnt(0)" : "=s"(p) : "s"(__builtin_amdgcn_kernarg_segment_ptr()), "i"(i * 8));
    return (const void*)p;
}
#define KIN(i) karg(i)
#define KOUT ((float*)karg(21))
#define KWS ((unsigned char*)karg(22))

#define XB_TMO      128
#define XB_XCNT(j)  (256  + 64 * (j))
#define XB_XSUB(j)  (1280 + 64 * (j))
#define XB_XGEN(j)  (2304 + 64 * (j))
#define XB_TOP      3328
#define XB_TOPGEN   3392
#define XCD_BAR_WORDS 3456
#define XB_SPIN_CAP (1u << 20)
DI unsigned xb_ld(unsigned* p)              { return __hip_atomic_load(p, __ATOMIC_RELAXED, __HIP_MEMORY_SCOPE_AGENT); }
DI unsigned xb_add(unsigned* p, unsigned v) { return __hip_atomic_fetch_add(p, v, __ATOMIC_RELAXED, __HIP_MEMORY_SCOPE_AGENT); }
DI unsigned xb_xcc_id() { return (unsigned)__builtin_amdgcn_s_getreg((3 << 11) | 20) & 0xFu; }
#define XB_SPIN(cond, bar) do { unsigned _sp = 0; while (cond) { __builtin_amdgcn_s_sleep(1); \
    if ((++_sp & 255u) == 0u) { if (xb_ld(&(bar)[XB_TMO])) break; if (_sp > XB_SPIN_CAP) { atomicAdd(&(bar)[XB_TMO], 1u); break; } } } } while (0)
DI void xcd_barrier_complete(unsigned* bar, unsigned x, unsigned& nloc, unsigned& nx) {
    const unsigned G = gridDim.x;
    unsigned sum, cnt, mine, sp = 0u;
    for (;;) {
        sum = 0u; cnt = 0u; mine = 0u;
#pragma unroll
        for (unsigned j = 0; j < 16; ++j) { const unsigned c = xb_ld(&bar[XB_XCNT(j)]); sum += c; cnt += (c > 0u) ? 1u : 0u; mine = (j == x) ? c : mine; }
        if (sum == G) break;
        __builtin_amdgcn_s_sleep(1);
        if ((++sp & 255u) == 0u) { if (xb_ld(&bar[XB_TMO])) break; if (sp > XB_SPIN_CAP) { atomicAdd(&bar[XB_TMO], 1u); break; } }
    }
    nloc = mine > 0u ? mine : 1u; nx = cnt > 0u ? cnt : 1u;
}
constexpr int LDS_MISC = 147456 - 64;
DI void grid_bar(unsigned& nbar) {
    asm volatile("s_waitcnt vmcnt(0)" ::: "memory");
    __syncthreads();
    if (threadIdx.x == 0) {
        unsigned* bar = (unsigned*)(KWS + WS_SMALL + 16384);
        volatile LAS unsigned* st = (volatile LAS unsigned*)(LDS_MISC);
        const unsigned x = xb_xcc_id();
        __builtin_amdgcn_s_waitcnt(0);
        unsigned nloc = st[0], nx = st[1];
        if (nloc == 0u) { xcd_barrier_complete(bar, x, nloc, nx); st[0] = nloc; st[1] = nx; }
        const unsigned old = xb_add(&bar[XB_XSUB(x)], 1u);
        const unsigned gen = old / nloc;
        if (old + 1u == (gen + 1u) * nloc) {
            __builtin_amdgcn_fence(__ATOMIC_RELEASE, "agent");
            asm volatile("s_waitcnt vmcnt(0)" ::: "memory");
            const unsigned og = xb_add(&bar[XB_TOP], 1u);
            const unsigned tg = og / nx;
            if (og + 1u == (tg + 1u) * nx) xb_add(&bar[XB_TOPGEN], 1u);
            else XB_SPIN(xb_ld(&bar[XB_TOPGEN]) == tg, bar);
            __builtin_amdgcn_fence(__ATOMIC_ACQUIRE, "agent");
            xb_add(&bar[XB_XGEN(x)], 1u);
            asm volatile("s_waitcnt vmcnt(0)" ::: "memory");
        } else {
            XB_SPIN(xb_ld(&bar[XB_XGEN(x)]) == gen, bar);
            __builtin_amdgcn_fence(__ATOMIC_ACQUIRE, "agent");
            asm volatile("s_waitcnt vmcnt(0)" ::: "memory");
        }
    }
    __syncthreads();
    nbar += 1u;
}
struct EpiFinal {
    static constexpr bool PERM = true;
    const bf16_t* HB; float* out; int ldc; float* ss; const float* g;
    DI void operator()(const pg8::f32x4 (&acc)[2][2][4][2], const pg8::Unit& u, int wr, int wc, int fr, int fq) const {
        const int row0 = u.pm * pg8::BM + wr * 64 + fr; const int col0 = u.pn * pg8::BM + wc * 32 + 8 * fq;
        f32x4 v[2][4][2][2];
#pragma unroll
        for (int ai = 0; ai < 2; ++ai)
#pragma unroll
            for (int m = 0; m < 4; ++m) { const int row = row0 + ai * pg8::HALF + m * 16; const size_t off = (size_t)row * ldc + col0; float s = 0.f;
#pragma unroll
                for (int bj = 0; bj < 2; ++bj) { const u32x4 h = *(const u32x4*)(HB + off + bj * pg8::HALF);
                    const f32x4 p0 = {__uint_as_float(h.x << 16), __uint_as_float(h.x & 0xffff0000u), __uint_as_float(h.y << 16), __uint_as_float(h.y & 0xffff0000u)};
                    const f32x4 p1 = {__uint_as_float(h.z << 16), __uint_as_float(h.z & 0xffff0000u), __uint_as_float(h.w << 16), __uint_as_float(h.w & 0xffff0000u)};
                    const f32x4 v0 = p0 + acc[ai][bj][m][0], v1 = p1 + acc[ai][bj][m][1]; v[ai][m][bj][0] = v0; v[ai][m][bj][1] = v1;
                    s += ((v0[0] * v0[0] + v0[1] * v0[1]) + (v0[2] * v0[2] + v0[3] * v0[3])) + ((v1[0] * v1[0] + v1[1] * v1[1]) + (v1[2] * v1[2] + v1[3] * v1[3])); }
                s += __shfl_xor(s, 16); s += __shfl_xor(s, 32);
                if (fq == 0) ss[(size_t)row * 32 + u.pn * 4 + wc] = s; }
        unsigned dummy = 0u; grid_bar(dummy);
#pragma unroll
        for (int bj = 0; bj < 2; ++bj) { const f32x4 g0 = *(const f32x4*)(g + col0 + bj * pg8::HALF), g1 = *(const f32x4*)(g + col0 + bj * pg8::HALF + 4);
#pragma unroll
            for (int ai = 0; ai < 2; ++ai)
#pragma unroll
                for (int m = 0; m < 4; ++m) { const int row = row0 + ai * pg8::HALF + m * 16; const float rs = 1.0f / sqrtf(pg8::row_ss(ss, row, fq) * (1.f / 2048.f) + 1e-6f);
                    float* o = out + (size_t)row * ldc + col0 + bj * pg8::HALF; *(f32x4*)o = v[ai][m][bj][0] * rs * g0; *(f32x4*)(o + 4) = v[ai][m][bj][1] * rs * g1; } }
    }
};

constexpr int CV_IN = 32 * 96, CV_SQ = 32 * 32, CV_WQ = DM, CV_KV = 32 * 64, CV_UP = 32 * 128, CV_DN = 128 * 32;
constexpr int CV_LAYER = CV_IN + 2 * CV_SQ + CV_WQ + CV_KV + CV_UP + CV_DN;
constexpr int CV_L1_LO = CV_IN + CV_SQ, CV_L1_HI = CV_IN + 2 * CV_SQ + CV_WQ + CV_KV;
DI void conv_item(int l, int r, LAS float* scr, int lane) {
    unsigned char* wt = KWS + WS_WT + (size_t)l * WT_LAYER;
    if (r < CV_IN) { transpose_item((const float*)KIN(4) + (size_t)l * DM * INC, DM, INC, (bf16_t*)(wt + WT_IN), scr, r, lane, (const float*)KIN(3) + l * DM); return; } r -= CV_IN;
    if (r < CV_SQ) { transpose_item((const float*)KIN(11) + (size_t)l * DM * DM, DM, DM, (bf16_t*)(wt + WT_OUT), scr, r, lane, nullptr); return; } r -= CV_SQ;
    if (r < CV_WQ) { scaled_row_bf16((const float*)KIN(14) + (size_t)l * DM * DM + (size_t)r * DM, ((const float*)KIN(12))[l * DM + r], (bf16_t*)(wt + WT_Q) + (size_t)r * DM, lane); return; } r -= CV_WQ;
    if (r < CV_KV) { transpose_item((const float*)KIN(15) + (size_t)l * DM * 2 * DM, DM, 2 * DM, (bf16_t*)(wt + WT_KV), scr, r, lane, nullptr); return; } r -= CV_KV;
    if (r < CV_SQ) { transpose_item((const float*)KIN(16) + (size_t)l * DM * DM, DM, DM, (bf16_t*)(wt + WT_O), scr, r, lane, nullptr); return; } r -= CV_SQ;
    if (r < CV_UP) { transpose_item((const float*)KIN(18) + (size_t)l * DM * FF, DM, FF, (bf16_t*)(wt + WT_UP), scr, r, lane, (const float*)KIN(17) + l * DM); return; } r -= CV_UP;
    transpose_item((const float*)KIN(19) + (size_t)l * FF * DM, FF, DM, (bf16_t*)(wt + WT_DOWN), scr, r, lane, nullptr);
}
DI void conv_idle(int first, int lo_, int hi_, LAS unsigned char* lds) {
    const int tid = threadIdx.x, lane = tid & 63, wave = __builtin_amdgcn_readfirstlane(tid >> 6);
    const int nb = (int)gridDim.x - first; if ((int)gridDim.x < 256 || (int)blockIdx.x < first || nb <= 0) return;
    LAS float* scr = (LAS float*)(lds + wave * 16640);
    for (int it = lo_ + ((int)blockIdx.x - first) * NWAVES + wave; it < hi_; it += nb * NWAVES) conv_item(1, it, scr, lane);
}

typedef pg8::ZNone ZN;

#define IN(k) (lo <= (k) && (k) < hi)
#define SEAM(k) do { if (IN(k) && IN((k) + 1)) grid_bar(nbar); } while (0)

template <int L>
DI void layer_fwd(LAS unsigned char* lds, unsigned& nbar, const int lo, const int hi) {
    const int tid = threadIdx.x, lane = tid & 63, wave = __builtin_amdgcn_readfirstlane(tid >> 6);
    const int G = gridDim.x, bx = blockIdx.x;
    const int gw = bx * NWAVES + wave, NGW = G * NWAVES;
    constexpr int P0 = 3 + L * PH_PER_LAYER;
#define WSP(T, off) ((T*)(KWS + (off)))
#define WTP(off) ((const bf16_t*)(KWS + WS_WT + (size_t)L * WT_LAYER + (off)))
#define SSP(i) ((float*)(KWS + WS_SS) + (size_t)(i) * TOK * 32)
#define hbuf KOUT
    if (IN(P0 + 0)) {
        pg8::EpiBf16<ZN> E{WSP(bf16_t, WS_RA), INC, 0, SSP(3 * L), 1}; pg8::Order S; S.init(TOK, INC, 1, G, bx);
        pg8::gemm_phase<pg8::EpiBf16<ZN>, DM, DM, DM, ZN, ZN>(lds, WSP(bf16_t, WS_XN), WTP(WT_IN), S, E);
    }
    SEAM(P0 + 0);
    if (IN(P0 + 1)) {
        const int* pos = (const int*)KIN(2); const int* pmn = WSP(int, WS_SMALL); const int* pmx = pmn + 128;
        const bf16_t* QKV = WSP(bf16_t, WS_RA); bf16_t* OMIX = WSP(bf16_t, WS_RA + 96 * MiB);
        const float li = 0.8f - 0.6f * expf(-0.3f * (float)L);
        const float* lq1 = (const float*)KIN(5) + L * 64; const float* lk1 = (const float*)KIN(6) + L * 64;
        const float* lq2 = (const float*)KIN(7) + L * 64; const float* lk2 = (const float*)KIN(8) + L * 64;
        float d1 = 0.f, d2 = 0.f;
        for (int i = 0; i < 64; ++i) { d1 += lq1[i] * lk1[i]; d2 += lq2[i] * lk2[i]; }
        const float lam = expf(d1) - expf(d2) + li;
        const float* sgd = (const float*)KIN(9) + L * 128; const float* sgs = (const float*)KIN(10) + L * 128;
        const int vcu = (G % 8 == 0) ? (bx % 8) * (G / 8) + bx / 8 : bx;
        for (int u = vcu; u < 256; u += G) { const int bh = u >> 3, sx = u & 7;
            for (int half = 0; half < 2; ++half)
                att::diff_unit((LAS char*)lds, QKV, OMIX, pos, pmn, pmx, bh >> 3, bh & 7, half == 0 ? 15 - sx : sx, lam, 1.0f - li, sgd, tid); }
        __syncthreads();
        for (int u = vcu; u < 256; u += G) { const int bh = u >> 3, qb = u & 7;
            att::sb_unit((LAS char*)lds, QKV, OMIX, pos, pmn, pmx, bh >> 3, bh & 7, qb, sgs, tid); }
    }
    SEAM(P0 + 1);
    if (IN(P0 + 2)) {
        pg8::EpiResid E{(L == 0) ? (const float*)KIN(0) : (const float*)nullptr, WSP(bf16_t, WS_XN), DM, SSP(3 * L + 1), 0}; pg8::Order S; S.init(TOK, DM, 1, G, bx);
        pg8::gemm_phase<pg8::EpiResid, DM, DM, DM, ZN, ZN>(lds, WSP(bf16_t, WS_RA + 96 * MiB), WTP(WT_OUT), S, E);
    }
    SEAM(P0 + 2);
    if (IN(P0 + 3)) {
        typedef pg8::ZOffT<1, (long)SEQ * DM, 0> ZXB; typedef pg8::ZOffT<1, (long)1024 * DM, 0> ZQB; typedef pg8::ZOffT<1, (long)SEQ * 1024, 0> ZPB;
        pg8::EpiSoftmax<ZPB> E{WSP(bf16_t, WS_RA + 64 * MiB), 1024, 0.044194173824159216f * LOG2E, SSP(3 * L + 1), SEQ}; pg8::Order S; S.init(SEQ, 1024, NB, G, bx);
        pg8::gemm_phase<pg8::EpiSoftmax<ZPB>, DM, DM, DM, ZXB, ZQB>(lds, WSP(bf16_t, WS_XN), WSP(bf16_t, WS_QKW + (size_t)L * 16 * MiB), S, E);
        if (L == 0) conv_idle(128, CV_L1_HI, CV_L1_HI + CV_UP, lds);
        else conv_idle(128, CV_L1_HI + CV_UP, CV_LAYER, lds);
    }
    SEAM(P0 + 3);
    if (IN(P0 + 4)) {
        typedef pg8::ZOffT<1, (long)SEQ * 1024, 0> ZPB;
        pg8::EpiResid E{nullptr, WSP(bf16_t, WS_XN), DM, SSP(3 * L + 2), SEQ}; pg8::Order S; S.init(SEQ, DM, NB, G, bx);
        pg8::gemm_phase<pg8::EpiResid, 1024, 1024, 1024, ZPB, ZPB>(lds, WSP(bf16_t, WS_RA + 64 * MiB), WSP(bf16_t, WS_VW + (size_t)L * 16 * MiB), S, E);
    }
    SEAM(P0 + 4);
    if (IN(P0 + 5)) {
        pg8::EpiBf16<ZN> E{WSP(bf16_t, WS_RA), FF, 1, SSP(3 * L + 2)}; pg8::Order S; S.init(TOK, FF, 1, G, bx);
        pg8::gemm_phase<pg8::EpiBf16<ZN>, DM, DM, DM, ZN, ZN>(lds, WSP(bf16_t, WS_XN), WTP(WT_UP), S, E);
    }
    SEAM(P0 + 5);
    const bool fuse_final = (L == NLAYER - 1) && G == 256 && IN(P0 + 6) && IN(P0 + 7);
    if (IN(P0 + 6)) {
        pg8::Order S; S.init(TOK, DM, 1, G, bx);
        if (fuse_final) {
            EpiFinal E{WSP(bf16_t, WS_XN), hbuf, DM, SSP(3 * L + 3), (const float*)KIN(20)};
            pg8::gemm_phase<EpiFinal, FF, FF, FF, ZN, ZN>(lds, WSP(bf16_t, WS_RA), WTP(WT_DOWN), S, E);
        } else {
            pg8::EpiResid E{nullptr, WSP(bf16_t, WS_XN), DM, SSP(3 * L + 3), 0};
            pg8::gemm_phase<pg8::EpiResid, FF, FF, FF, ZN, ZN>(lds, WSP(bf16_t, WS_RA), WTP(WT_DOWN), S, E);
        }
    }
    if (!fuse_final) {
        SEAM(P0 + 6);
        if (L == NLAYER - 1) {
            if (IN(P0 + 7)) { const float* gsel = (const float*)KIN(20); const float* ssf = SSP(3 * NLAYER);
                for (int m = gw; m < TOK; m += NGW) scale_row_out(WSP(bf16_t, WS_XN) + (size_t)m * DM, hbuf + (size_t)m * DM, gsel, wave_sum(lane < 32 ? ssf[(size_t)m * 32 + lane] : 0.f), lane); }
        }
    }
#undef WSP
#undef WTP
#undef SSP
#undef hbuf
}

__global__ void __launch_bounds__(NWAVES * 64, 2) mega_fwd(Args args) {
    extern __shared__ __attribute__((aligned(16))) unsigned char lds_raw[];
    LAS unsigned char* lds = (LAS unsigned char*)lds_raw;
    cg::grid_group grid = cg::this_grid();
    const int lo = args.ph_lo, hi = args.ph_hi;
    if (threadIdx.x == 0) { volatile LAS unsigned* st = (volatile LAS unsigned*)(LDS_MISC); st[0] = 0u; st[1] = 0u;
        (void)xb_add(&((unsigned*)(KWS + WS_SMALL + 16384))[XB_XCNT(xb_xcc_id())], 1u); }
    __syncthreads();
    if (IN(0)) {
        const int tid = threadIdx.x, lane = tid & 63, wave = __builtin_amdgcn_readfirstlane(tid >> 6);
        const int gw = blockIdx.x * NWAVES + wave, NGW = gridDim.x * NWAVES;
        unsigned char* const ws = KWS;
        LAS float* scr = (LAS float*)(lds + wave * 16640);
        if (gridDim.x >= 256) { for (int it = gw; it < CV_LAYER + (CV_L1_HI - CV_L1_LO); it += NGW) { if (it < CV_LAYER) conv_item(0, it, scr, lane); else conv_item(1, CV_L1_LO + it - CV_LAYER, scr, lane); } }
        else { for (int it = gw; it < 2 * CV_LAYER; it += NGW) conv_item(it / CV_LAYER, it % CV_LAYER, scr, lane); }
        const float* x = (const float*)KIN(0); const float* mem = (const float*)KIN(1); const int* pos = (const int*)KIN(2);
        float* ssb = (float*)(ws + WS_SS);
        for (int m = gw; m < TOK; m += NGW) prep_row(x + (size_t)m * DM, (bf16_t*)(ws + WS_XN) + (size_t)m * DM, ssb + (size_t)m * 32, lane);
        for (int m = gw; m < NLAYER * NB * NMEM; m += NGW) { const int l = m / (NB * NMEM), r = m % (NB * NMEM);
            rms_row_bf16(mem + (size_t)r * DM, (const float*)KIN(13) + l * DM, (bf16_t*)(ws + WS_MEMN + (size_t)l * 4 * MiB) + (size_t)r * DM, nullptr, lane); }
        int* pmn = (int*)(ws + WS_SMALL); int* pmx = pmn + 128;
        for (int m = gw; m < 128; m += NGW) { const int p = pos[m * 64 + lane]; const int mn = wave_mini(p), mx = wave_maxi(p); if (lane == 0) { pmn[m] = mn; pmx[m] = mx; } }
    }
    unsigned nbar = 0u;
    if (lo < 0) grid.sync();
    SEAM(0);
    if (IN(1)) {
        const int bx = blockIdx.x;
        if (bx < 128) {
            const int l = bx >> 6; unsigned char* const ws = KWS;
            pg8::EpiBf16<ZN> E{(bf16_t*)(ws + WS_KVX + (size_t)l * 8 * MiB), 2 * DM, 0, nullptr};
            pg8::Order S; S.init(NB * NMEM, 2 * DM, 1, 64, bx & 63);
            pg8::gemm_phase<pg8::EpiBf16<ZN>, DM, DM, DM, ZN, ZN>(lds, (const bf16_t*)(ws + WS_MEMN + (size_t)l * 4 * MiB), (const bf16_t*)(ws + WS_WT + (size_t)l * WT_LAYER + WT_KV), S, E);
        }
        conv_idle(128, 0, CV_L1_LO, lds);
    }
    SEAM(1);
    if (IN(2)) {
        const int bx = blockIdx.x; unsigned char* const ws = KWS;
        typedef pg8::ZOffT<4, (long)NMEM * 4096, 512> ZKV;
        typedef pg8::ZOffT<4, 0, 512> ZHD;
        typedef pg8::ZOffT<4, (long)1024 * DM, (long)NMEM * DM> ZQKW;
        typedef pg8::ZOffT<4, (long)SEQ * 1024, 256> ZVW;
        for (int l = 0; l < NLAYER; ++l) {
            const bf16_t* kvx = (const bf16_t*)(ws + WS_KVX + (size_t)l * 8 * MiB);
            if (bx < 128) {
                pg8::EpiBf16<ZQKW> E{(bf16_t*)(ws + WS_QKW + (size_t)l * 16 * MiB), DM, 0, nullptr};
                pg8::Order S; S.init(NMEM, DM, 16, 128, bx);
                pg8::gemm_phase<pg8::EpiBf16<ZQKW>, 512, 4096, DM, ZKV, ZHD>(lds, kvx, (const bf16_t*)(ws + WS_WT + (size_t)l * WT_LAYER + WT_Q), S, E);
            } else {
                pg8::EpiBf16<ZVW> E{(bf16_t*)(ws + WS_VW + (size_t)l * 16 * MiB), 1024, 0, nullptr};
                pg8::Order S; S.init(DM, NMEM, 16, 128, bx - 128);
                pg8::gemm_phase<pg8::EpiBf16<ZVW>, 512, DM, 4096, ZHD, ZKV>(lds, (const bf16_t*)(ws + WS_WT + (size_t)l * WT_LAYER + WT_O), kvx + DM, S, E);
            }
        }
    }
    layer_fwd<0>(lds, nbar, lo, hi);
    layer_fwd<1>(lds, nbar, lo, hi);
}

extern "C" void kernel_launch(void* const* d_in, const int* in_sizes, int n_in, void* d_out, int out_size, void* d_ws, size_t ws_size, hipStream_t stream) {
    static int grid = 0;
    if (grid == 0) {
        if (n_in != 21 || out_size != TOK * DM || ws_size < WS_END) { fprintf(stderr, "kernel_launch: unexpected shapes (n_in %d out %d ws %zu)\n", n_in, out_size, ws_size); grid = -1; return; }
        int dev = 0, cus = 0, per_cu = 0;
        hipGetDevice(&dev); hipDeviceGetAttribute(&cus, hipDeviceAttributeMultiprocessorCount, dev);
        hipFuncSetAttribute((const void*)mega_fwd, hipFuncAttributeMaxDynamicSharedMemorySize, LDS_BYTES);
        hipOccupancyMaxActiveBlocksPerMultiprocessor(&per_cu, (const void*)mega_fwd, NWAVES * 64, LDS_BYTES);
        if (per_cu < 1) { fprintf(stderr, "kernel_launch: occupancy query says %d blocks per CU\n", per_cu); per_cu = 1; }
        (void)hipGetLastError();
        grid = cus * per_cu;
    }
    if (grid < 0) return;
    if (hipMemsetAsync((char*)d_ws + WS_SMALL + 16384, 0, XCD_BAR_WORDS * 4, stream) != hipSuccess) { fprintf(stderr, "kernel_launch: memset failed\n"); return; }
    Args a{};
    for (int i = 0; i < 21; ++i) a.in[i] = d_in[i];
    a.out = (float*)d_out; a.ws = (unsigned char*)d_ws; a.ph_lo = 0; a.ph_hi = N_PHASES;
    void* kargs[] = {&a};
    hipError_t e = hipLaunchCooperativeKernel((const void*)mega_fwd, dim3(grid), dim3(NWAVES * 64), kargs, LDS_BYTES, stream);
    if (e != hipSuccess) fprintf(stderr, "cooperative launch failed: %s (grid %d)\n", hipGetErrorString(e), grid);
}
```

```cpp
#include <hip/hip_runtime.h>
#include <hip/hip_cooperative_groups.h>
#include <cstdio>
#include <cstdint>
namespace cg = cooperative_groups;

#define DI __device__ __forceinline__
#define LAS __attribute__((address_space(3)))

constexpr int NB = 4, SEQ = 2048, DM = 2048, TOK = NB * SEQ, INC = 6144, FF = 8192, NMEM = 256, NLAYER = 2;
constexpr int C_DQ = 0, C_DK = 1024, C_DV = 2048, C_SQ = 3072, C_SK = 4096, C_SV = 5120;
constexpr float EPS = 1e-6f, LOG2E = 1.4426950408889634f, LN2 = 0.6931471805599453f;

constexpr size_t MiB = 1u << 20;
constexpr size_t WS_WT = 0;
constexpr size_t WT_IN = 0, WT_OUT = 24 * MiB, WT_Q = 32 * MiB, WT_KV = 40 * MiB, WT_O = 56 * MiB, WT_UP = 64 * MiB, WT_DOWN = 96 * MiB, WT_LAYER = 128 * MiB;
constexpr size_t WS_XN = 256 * MiB;
constexpr size_t WS_RA = 288 * MiB;
constexpr size_t WS_MEMN = 416 * MiB;
constexpr size_t WS_KVX = 424 * MiB;
constexpr size_t WS_SMALL = 440 * MiB;
constexpr size_t WS_QKW = 441 * MiB;
constexpr size_t WS_VW = 473 * MiB;
constexpr size_t WS_SS = 505 * MiB;
constexpr size_t WS_END = 513 * MiB;

namespace pg8 {
typedef unsigned short bf16_t;
typedef short bf16x8 __attribute__((ext_vector_type(8)));
typedef float f32x4 __attribute__((ext_vector_type(4)));
typedef unsigned u32x4 __attribute__((ext_vector_type(4)));
constexpr int BM = 256, BK = 64, HALF = 128, HTB = HALF * BK * 2, STAGE_BYTES = 8 * HTB, NXCD = 8, WGM = 8;

DI int lds_byte(int r, int c) { const int st = (r >> 4) * 2 + (c >> 5), rr = r & 15, cc = c & 31, ob = rr * 64 + cc * 2; return st * 1024 + (ob ^ (((ob >> 9) & 1) << 5)); }
DI void stage_rc(int b, int& R, int& C) { const int st = b / 1024, sb = b % 1024, swz = sb ^ (((sb >> 9) & 1) << 5); R = (st >> 1) * 16 + swz / 64; C = (st & 1) * 32 + (swz % 64) / 2; }
DI int perm32(int rho) { const int n = rho >> 4, i = rho & 15; return 8 * (i >> 2) + 4 * n + (i & 3); }

struct Unit { int pm, pn, z; };
template <int ZDIV, long S0, long S1> struct ZOffT { static DI long off(int z) { return (long)(z / ZDIV) * S0 + (long)(z % ZDIV) * S1; } };
struct ZNone { static DI long off(int) { return 0; } };

struct Order {
    int nM, nN, nZ, nwg, G, c;
    DI void init(int M, int N, int Z, int G_, int c_) { nM = M / BM; nN = N / BM; nZ = Z; nwg = nM * nN * Z; G = G_; c = c_; }
    DI bool next(int i, Unit& u) const {
        const long L = (long)i * G + c; if (L >= nwg) return false;
        int wgid = (int)L; { const int q = nwg / NXCD, r = nwg % NXCD, xcd = wgid % NXCD, off = wgid / NXCD; wgid = (xcd < r ? xcd * (q + 1) : r * (q + 1) + (xcd - r) * q) + off; }
        if (nZ == 1) {
            const int nig = WGM * nN, gid = wgid / nig, fm = gid * WGM, gsz = (nM - fm) < WGM ? (nM - fm) : WGM;
            u.pm = fm + ((wgid % nig) % gsz); u.pn = (wgid % nig) / gsz; u.z = 0;
        } else {
            const int per = nM * nN; u.z = wgid / per; const int r = wgid % per; u.pn = r % nN; u.pm = r / nN;
        }
        return true;
    }
};

DI float row_ss(const float* ssp, int row, int fq) {
    const f32x4* p = (const f32x4*)(ssp + (size_t)row * 32 + fq * 8); const f32x4 a = p[0], b = p[1];
    float s = ((a[0] + a[1]) + (a[2] + a[3])) + ((b[0] + b[1]) + (b[2] + b[3]));
    s += __shfl_xor(s, 16); s += __shfl_xor(s, 32); return s;
}
DI unsigned cvt_pk_bf16(float lo, float hi) { unsigned r; asm volatile("v_cvt_pk_bf16_f32 %0, %1, %2" : "=v"(r) : "v"(lo), "v"(hi)); return r; }

template <class ZO> struct EpiBf16 {
    static constexpr bool PERM = true;
    bf16_t* O; int ldc; int act; const float* ss;
    DI void operator()(const f32x4 (&acc)[2][2][4][2], const Unit& u, int wr, int wc, int fr, int fq) const {
        const int row0 = u.pm * BM + wr * 64 + fr; const int col0 = u.pn * BM + wc * 32 + 8 * fq;
        bf16_t* base = O + ZO::off(u.z);
#pragma unroll
        for (int ai = 0; ai < 2; ++ai)
#pragma unroll
            for (int m = 0; m < 4; ++m) { bf16_t* rowp = base + (size_t)(row0 + ai * HALF + m * 16) * ldc + col0;
                const float rs = ss ? 1.0f / sqrtf(row_ss(ss, row0 + ai * HALF + m * 16, fq) * (1.f / 2048.f) + 1e-6f) : 1.0f;
#pragma unroll
                for (int bj = 0; bj < 2; ++bj) { f32x4 v0 = acc[ai][bj][m][0] * rs, v1 = acc[ai][bj][m][1] * rs;
                    if (act == 1) {
#pragma unroll
                        for (int e = 0; e < 4; ++e) { const float a = fmaxf(v0[e], 0.f), b = fmaxf(v1[e], 0.f); v0[e] = a * a; v1[e] = b * b; } }
                    u32x4 w; w.x = cvt_pk_bf16(v0[0], v0[1]); w.y = cvt_pk_bf16(v0[2], v0[3]); w.z = cvt_pk_bf16(v1[0], v1[1]); w.w = cvt_pk_bf16(v1[2], v1[3]);
                    *(u32x4*)(rowp + bj * HALF) = w; } }
    }
};
struct EpiResid {
    static constexpr bool PERM = true;
    const float* Xin; bf16_t* HB; int ldc; float* ss; int zrows;
    DI void operator()(const f32x4 (&acc)[2][2][4][2], const Unit& u, int wr, int wc, int fr, int fq) const {
        const int row0 = u.z * zrows + u.pm * BM + wr * 64 + fr; const int col0 = u.pn * BM + wc * 32 + 8 * fq;
#pragma unroll
        for (int ai = 0; ai < 2; ++ai)
#pragma unroll
            for (int m = 0; m < 4; ++m) { const int row = row0 + ai * HALF + m * 16; const size_t off = (size_t)row * ldc + col0; float s = 0.f;
#pragma unroll
                for (int bj = 0; bj < 2; ++bj) { const size_t o2 = off + bj * HALF; f32x4 p0, p1;
                    if (Xin) { p0 = *(const f32x4*)(Xin + o2); p1 = *(const f32x4*)(Xin + o2 + 4); }
                    else { const u32x4 h = *(const u32x4*)(HB + o2);
                        p0 = (f32x4){__uint_as_float(h.x << 16), __uint_as_float(h.x & 0xffff0000u), __uint_as_float(h.y << 16), __uint_as_float(h.y & 0xffff0000u)};
                        p1 = (f32x4){__uint_as_float(h.z << 16), __uint_as_float(h.z & 0xffff0000u), __uint_as_float(h.w << 16), __uint_as_float(h.w & 0xffff0000u)}; }
                    const f32x4 v0 = p0 + acc[ai][bj][m][0], v1 = p1 + acc[ai][bj][m][1];
                    s += ((v0[0] * v0[0] + v0[1] * v0[1]) + (v0[2] * v0[2] + v0[3] * v0[3])) + ((v1[0] * v1[0] + v1[1] * v1[1]) + (v1[2] * v1[2] + v1[3] * v1[3]));
                    u32x4 w; w.x = cvt_pk_bf16(v0[0], v0[1]); w.y = cvt_pk_bf16(v0[2], v0[3]); w.z = cvt_pk_bf16(v1[0], v1[1]); w.w = cvt_pk_bf16(v1[2], v1[3]);
                    *(u32x4*)(HB + o2) = w; }
                s += __shfl_xor(s, 16); s += __shfl_xor(s, 32);
                if (fq == 0) ss[(size_t)row * 32 + u.pn * 4 + wc] = s; }
    }
};
template <class ZO> struct EpiSoftmax {
    static constexpr bool PERM = false;
    bf16_t* P; int ldc; float scale2; const float* ss; int zrows;
    DI void operator()(const f32x4 (&acc)[2][2][4][2], const Unit& u, int wr, int wc, int fr, int fq) const {
        LAS float* TM = (LAS float*)(131072); LAS float* TS = TM + 1024;
        f32x4 v[2][4][2][2]; float mx[2][4];
#pragma unroll
        for (int ai = 0; ai < 2; ++ai)
#pragma unroll
            for (int m = 0; m < 4; ++m) { float t = -3.0e38f;
                const float rs = scale2 / sqrtf(row_ss(ss, u.z * zrows + u.pm * BM + ai * HALF + wr * 64 + m * 16 + fr, fq) * (1.f / 2048.f) + 1e-6f);
#pragma unroll
                for (int bj = 0; bj < 2; ++bj)
#pragma unroll
                    for (int n = 0; n < 2; ++n) { const f32x4 x = acc[ai][bj][m][n] * rs; v[ai][m][bj][n] = x; t = fmaxf(t, fmaxf(fmaxf(x[0], x[1]), fmaxf(x[2], x[3]))); }
                t = fmaxf(t, __shfl_xor(t, 16)); t = fmaxf(t, __shfl_xor(t, 32));
                if (fq == 0) TM[(ai * HALF + wr * 64 + m * 16 + fr) * 4 + wc] = t; }
        asm volatile("s_waitcnt lgkmcnt(0)" ::: "memory"); __builtin_amdgcn_s_barrier(); asm volatile("" ::: "memory");
#pragma unroll
        for (int ai = 0; ai < 2; ++ai)
#pragma unroll
            for (int m = 0; m < 4; ++m) { const f32x4 t4 = *(const LAS f32x4*)(TM + (ai * HALF + wr * 64 + m * 16 + fr) * 4);
                const float rm = fmaxf(fmaxf(t4[0], t4[1]), fmaxf(t4[2], t4[3])); float s = 0.f;
#pragma unroll
                for (int bj = 0; bj < 2; ++bj)
#pragma unroll
                    for (int n = 0; n < 2; ++n) { f32x4 x = v[ai][m][bj][n];
#pragma unroll
                        for (int e = 0; e < 4; ++e) x[e] = __builtin_amdgcn_exp2f(x[e] - rm);
                        v[ai][m][bj][n] = x; s += (x[0] + x[1]) + (x[2] + x[3]); }
                s += __shfl_xor(s, 16); s += __shfl_xor(s, 32);
                if (fq == 0) TS[(ai * HALF + wr * 64 + m * 16 + fr) * 4 + wc] = s; }
        asm volatile("s_waitcnt lgkmcnt(0)" ::: "memory"); __builtin_amdgcn_s_barrier(); asm volatile("" ::: "memory");
        const int row0 = u.pm * BM + wr * 64 + fr; const int col0 = u.pn * BM + wc * 32 + 4 * fq;
        bf16_t* base = P + ZO::off(u.z);
#pragma unroll
        for (int ai = 0; ai < 2; ++ai)
#pragma unroll
            for (int m = 0; m < 4; ++m) { const f32x4 s4 = *(const LAS f32x4*)(TS + (ai * HALF + wr * 64 + m * 16 + fr) * 4);
                const float inv = 1.0f / ((s4[0] + s4[1]) + (s4[2] + s4[3])); bf16_t* rowp = base + (size_t)(row0 + ai * HALF + m * 16) * ldc + col0;
#pragma unroll
                for (int bj = 0; bj < 2; ++bj)
#pragma unroll
                    for (int n = 0; n < 2; ++n) { const f32x4 x = v[ai][m][bj][n] * inv; typedef unsigned u32x2_t __attribute__((ext_vector_type(2)));
                        u32x2_t w; w.x = cvt_pk_bf16(x[0], x[1]); w.y = cvt_pk_bf16(x[2], x[3]); *(u32x2_t*)(rowp + bj * HALF + n * 16) = w; } }
        asm volatile("s_waitcnt lgkmcnt(0)" ::: "memory"); __builtin_amdgcn_s_barrier(); asm volatile("" ::: "memory");
    }
};

template <class Epi, int K, int LDA, int LDB, class ZA, class ZB>
DI void gemm_phase(LAS unsigned char* lds, const bf16_t* gA, const bf16_t* gBt, const Order& S, const Epi& E) {
    const int tid = threadIdx.x, wid = __builtin_amdgcn_readfirstlane(tid >> 6), lane = tid & 63, wr = wid >> 2, wc = wid & 3, fr = lane & 15, fq = lane >> 4;
    constexpr int nt = K / BK;
    unsigned voffA[2], voffB[2];
#pragma unroll
    for (int i = 0; i < 2; ++i) { int R, C; stage_rc(tid * 16 + i * 8192, R, C); const int Rb = Epi::PERM ? ((R & ~31) + perm32(R & 31)) : R;
        voffA[i] = (unsigned)(R * LDA + C) * 2u; voffB[i] = (unsigned)(Rb * LDB + C) * 2u; }
    constexpr size_t kstep = (size_t)(BK * 2);
    constexpr size_t hstepA = (size_t)HALF * LDA * 2, hstepB = (size_t)HALF * LDB * 2;
    constexpr size_t tstepA = 2 * hstepA, tstepB = 2 * hstepB;
    const unsigned ldsw = (unsigned)wid * 1024u;
    const int aoff = lds_byte(wr * 64 + fr, fq * 8), boff = lds_byte(wc * 32 + fr, fq * 8);
#define PG8_SA(b, h) (((b) * 2 + (h)) * HTB)
#define PG8_SB(b, h) ((4 + (b) * 2 + (h)) * HTB)
#define PG8_STAGE(bufoff, gbase, voff) do { _Pragma("unroll") for (int _i = 0; _i < 2; ++_i) \
        __builtin_amdgcn_global_load_lds((const unsigned*)((const char*)(gbase) + (voff)[_i]), (LAS unsigned*)(lds + (bufoff) + ldsw + _i * 8192), 16, 0, 0); } while (0)
#define PG8_LDA(dst, b, h) do { _Pragma("unroll") for (int m = 0; m < 4; ++m) _Pragma("unroll") for (int k = 0; k < 2; ++k) dst[m][k] = *(const LAS bf16x8*)(lds + PG8_SA(b, h) + aoff + m * 2048 + k * 1024); } while (0)
#define PG8_LDB(dst, b, h) do { _Pragma("unroll") for (int n = 0; n < 2; ++n) _Pragma("unroll") for (int k = 0; k < 2; ++k) dst[n][k] = *(const LAS bf16x8*)(lds + PG8_SB(b, h) + boff + n * 2048 + k * 1024); } while (0)
#define PG8_MMA(ai, bj, At, Bt) do { __builtin_amdgcn_s_setprio(1); _Pragma("unroll") for (int m = 0; m < 4; ++m) _Pragma("unroll") for (int n = 0; n < 2; ++n) _Pragma("unroll") for (int k = 0; k < 2; ++k) \
        acc[ai][bj][m][n] = __builtin_amdgcn_mfma_f32_16x16x32_bf16(Bt[n][k], At[m][k], acc[ai][bj][m][n], 0, 0, 0); __builtin_amdgcn_s_setprio(0); } while (0)
#define PG8_WAIT_V(n) asm volatile("s_waitcnt vmcnt(" #n ")" ::: "memory")
#define PG8_WAIT_L(n) asm volatile("s_waitcnt lgkmcnt(" #n ")" ::: "memory")
#define PG8_BAR __builtin_amdgcn_s_barrier()
#define PG8_SCHED __builtin_amdgcn_sched_barrier(0)
    Unit cur, nxt; int ui = 0;
    if (!S.next(0, cur)) return;
    f32x4 acc[2][2][4][2];
#pragma unroll
    for (int a = 0; a < 2; ++a)
#pragma unroll
        for (int b = 0; b < 2; ++b)
#pragma unroll
            for (int m = 0; m < 4; ++m)
#pragma unroll
                for (int n = 0; n < 2; ++n) acc[a][b][m][n] = (f32x4){0.f, 0.f, 0.f, 0.f};
    bf16x8 At[4][2], B0[2][2], B1[2][2];
    const char* cA = (const char*)gA + (size_t)ZA::off(cur.z) * 2 + (size_t)cur.pm * tstepA; const char* cB = (const char*)gBt + (size_t)ZB::off(cur.z) * 2 + (size_t)cur.pn * tstepB;
    PG8_STAGE(PG8_SB(0, 0), cB, voffB); PG8_STAGE(PG8_SB(0, 1), cB + hstepB, voffB); PG8_STAGE(PG8_SA(0, 0), cA, voffA); PG8_STAGE(PG8_SA(0, 1), cA + hstepA, voffA);
    if (wr == 1) PG8_BAR;
    PG8_WAIT_V(2); PG8_BAR;
    PG8_STAGE(PG8_SB(1, 0), cB + kstep, voffB); PG8_STAGE(PG8_SA(1, 0), cA + kstep, voffA); PG8_STAGE(PG8_SB(1, 1), cB + hstepB + kstep, voffB);
    PG8_WAIT_V(6); PG8_BAR;
    for (;;) {
        const bool has_next = S.next(ui + 1, nxt);
        const char* nA = has_next ? (const char*)gA + (size_t)ZA::off(nxt.z) * 2 + (size_t)nxt.pm * tstepA : cA; const char* nB = has_next ? (const char*)gBt + (size_t)ZB::off(nxt.z) * 2 + (size_t)nxt.pn * tstepB : cB;
#pragma unroll 1
        for (int t = 0; t < nt; t += 2) {
            const bool last = (t == nt - 2);
            const char* a1 = cA + (size_t)(t + 1) * kstep;
            const char* a2 = last ? nA : cA + (size_t)(t + 2) * kstep; const char* b2 = last ? nB : cB + (size_t)(t + 2) * kstep;
            const char* a3 = a2 + kstep; const char* b3 = b2 + kstep;
            PG8_LDB(B0, 0, 0); PG8_LDB(B1, 0, 1); PG8_SCHED; PG8_LDA(At, 0, 0); PG8_STAGE(PG8_SA(1, 1), a1 + hstepA, voffA);
            PG8_WAIT_V(8); PG8_WAIT_L(0); PG8_BAR; PG8_MMA(0, 0, At, B0); PG8_MMA(0, 1, At, B1); PG8_BAR; PG8_SCHED;
            PG8_LDA(At, 0, 1); PG8_STAGE(PG8_SB(0, 0), b2, voffB); PG8_STAGE(PG8_SB(0, 1), b2 + hstepB, voffB); PG8_STAGE(PG8_SA(0, 0), a2, voffA);
            PG8_WAIT_V(8); PG8_WAIT_L(0); PG8_BAR; PG8_MMA(1, 0, At, B0); PG8_MMA(1, 1, At, B1); PG8_BAR; PG8_SCHED;
            PG8_LDB(B0, 1, 0); PG8_LDB(B1, 1, 1); PG8_SCHED; PG8_LDA(At, 1, 0); PG8_STAGE(PG8_SA(0, 1), a2 + hstepA, voffA);
            PG8_WAIT_V(8); PG8_WAIT_L(0); PG8_BAR; PG8_MMA(0, 0, At, B0); PG8_MMA(0, 1, At, B1); PG8_BAR; PG8_SCHED;
            PG8_LDA(At, 1, 1); PG8_STAGE(PG8_SB(1, 0), b3, voffB); PG8_STAGE(PG8_SB(1, 1), b3 + hstepB, voffB); PG8_STAGE(PG8_SA(1, 0), a3, voffA);
            PG8_WAIT_V(8); PG8_WAIT_L(0); PG8_BAR; PG8_MMA(1, 0, At, B0); PG8_MMA(1, 1, At, B1); PG8_BAR; PG8_SCHED;
        }
        if (wr == 0) PG8_BAR;
        E(acc, cur, wr, wc, fr, fq);
        if (!has_next) break;
#pragma unroll
        for (int a = 0; a < 2; ++a)
#pragma unroll
            for (int b = 0; b < 2; ++b)
#pragma unroll
                for (int m = 0; m < 4; ++m)
#pragma unroll
                    for (int n = 0; n < 2; ++n) acc[a][b][m][n] = (f32x4){0.f, 0.f, 0.f, 0.f};
        cur = nxt; cA = nA; cB = nB; ++ui;
        if (wr == 1) PG8_BAR;
    }
    PG8_WAIT_V(0);
    PG8_BAR;
#undef PG8_SA
#undef PG8_SB
#undef PG8_STAGE
#undef PG8_LDA
#undef PG8_LDB
#undef PG8_MMA
#undef PG8_WAIT_V
#undef PG8_WAIT_L
#undef PG8_BAR
#undef PG8_SCHED
}
}

typedef unsigned short bf16_t;
typedef float f32x4 __attribute__((ext_vector_type(4)));
typedef float f32x16 __attribute__((ext_vector_type(16)));
typedef short bf16x8 __attribute__((ext_vector_type(8)));
typedef short s16x4 __attribute__((ext_vector_type(4)));
typedef unsigned u32x4 __attribute__((ext_vector_type(4)));
typedef unsigned u32x2 __attribute__((ext_vector_type(2)));
typedef int i32x4 __attribute__((ext_vector_type(4)));

DI unsigned f2bf(float f) { unsigned u = __builtin_bit_cast(unsigned, f); return (u + 0x7fffu + ((u >> 16) & 1u)) >> 16; }
DI unsigned pk2(float lo, float hi) { return f2bf(lo) | (f2bf(hi) << 16); }
DI float wave_sum(float v) {
#pragma unroll
    for (int o = 1; o < 64; o <<= 1) v += __shfl_xor(v, o);
    return v;
}
DI int wave_maxi(int v) {
#pragma unroll
    for (int o = 1; o < 64; o <<= 1) { const int w = __shfl_xor(v, o); v = w > v ? w : v; }
    return v;
}
DI int wave_mini(int v) {
#pragma unroll
    for (int o = 1; o < 64; o <<= 1) { const int w = __shfl_xor(v, o); v = w < v ? w : v; }
    return v;
}

DI void transpose_item(const float* W, int K, int N, bf16_t* WT, LAS float* scr, int item, int lane, const float* g) {
    const int nblk = N / 64, kb = item / nblk, nb = item % nblk, k0 = 64 * kb, n0 = 64 * nb;
    const int c4 = (lane & 15) * 4;
#pragma unroll 8
    for (int i = 0; i < 16; ++i) { const int kk = 4 * i + (lane >> 4); const f32x4 v = *(const f32x4*)(W + (size_t)(k0 + kk) * N + n0 + c4);
        LAS float* d = scr + kk * 65 + c4; d[0] = v.x; d[1] = v.y; d[2] = v.z; d[3] = v.w; }
    asm volatile("s_waitcnt lgkmcnt(0)" ::: "memory");
    const int c = lane & 7;
    f32x4 g0 = {1.f, 1.f, 1.f, 1.f}, g1 = {1.f, 1.f, 1.f, 1.f};
    if (g) { g0 = *(const f32x4*)(g + k0 + 8 * c); g1 = *(const f32x4*)(g + k0 + 8 * c + 4); }
#pragma unroll
    for (int j = 0; j < 8; ++j) { const int n = (lane >> 3) + 8 * j; const LAS float* s = scr + (8 * c) * 65 + n;
        u32x4 o; o.x = pk2(s[0 * 65] * g0.x, s[1 * 65] * g0.y); o.y = pk2(s[2 * 65] * g0.z, s[3 * 65] * g0.w); o.z = pk2(s[4 * 65] * g1.x, s[5 * 65] * g1.y); o.w = pk2(s[6 * 65] * g1.z, s[7 * 65] * g1.w);
        *(u32x4*)(WT + (size_t)(n0 + n) * K + k0 + 8 * c) = o; }
    asm volatile("s_waitcnt lgkmcnt(0)" ::: "memory");
}
DI void prep_row(const float* xrow, bf16_t* orow, float* ss, int lane) {
    const f32x4* xr = (const f32x4*)xrow + lane; f32x4 v[8]; float s = 0.f;
#pragma unroll
    for (int j = 0; j < 8; ++j) { v[j] = xr[64 * j]; s += (v[j].x * v[j].x + v[j].y * v[j].y) + (v[j].z * v[j].z + v[j].w * v[j].w); }
    s = wave_sum(s);
    u32x2* o8 = (u32x2*)orow + lane;
#pragma unroll
    for (int j = 0; j < 8; ++j) { u32x2 w; w.x = pk2(v[j].x, v[j].y); w.y = pk2(v[j].z, v[j].w); o8[64 * j] = w; }
    if (lane < 32) ss[lane] = (lane == 0) ? s : 0.f;
}
DI void scale_row_out(const bf16_t* hrow, float* orow, const float* g, float ssv, int lane) {
    const u32x2* hr = (const u32x2*)hrow + lane; f32x4* xr = (f32x4*)orow + lane; const f32x4* gr = (const f32x4*)g + lane; const float rstd = 1.0f / sqrtf(ssv * (1.f / DM) + EPS);
#pragma unroll
    for (int j = 0; j < 8; ++j) { const u32x2 h = hr[64 * j]; const f32x4 v = {__uint_as_float(h.x << 16), __uint_as_float(h.x & 0xffff0000u), __uint_as_float(h.y << 16), __uint_as_float(h.y & 0xffff0000u)};
        xr[64 * j] = v * rstd * gr[64 * j]; }
}
DI void scaled_row_bf16(const float* xrow, float sc, bf16_t* orow, int lane) {
    const f32x4* xr = (const f32x4*)xrow + lane; u32x2* o8 = (u32x2*)orow + lane;
#pragma unroll
    for (int j = 0; j < 8; ++j) { const f32x4 v = xr[64 * j] * sc; u32x2 w; w.x = pk2(v.x, v.y); w.y = pk2(v.z, v.w); o8[64 * j] = w; }
}
DI void rms_row_bf16(const float* xrow, const float* g, bf16_t* orow, float* copy, int lane) {
    const f32x4* xr = (const f32x4*)xrow + lane; f32x4 v[8]; float s = 0.f;
#pragma unroll
    for (int j = 0; j < 8; ++j) { v[j] = xr[64 * j]; s += (v[j].x * v[j].x + v[j].y * v[j].y) + (v[j].z * v[j].z + v[j].w * v[j].w); }
    const float rstd = 1.0f / sqrtf(wave_sum(s) * (1.f / DM) + EPS);
    const f32x4* gr = (const f32x4*)g + lane; u32x2* o8 = (u32x2*)orow + lane;
#pragma unroll
    for (int j = 0; j < 8; ++j) { const f32x4 gg = gr[64 * j]; u32x2 w; w.x = pk2(v[j].x * rstd * gg.x, v[j].y * rstd * gg.y); w.y = pk2(v[j].z * rstd * gg.z, v[j].w * rstd * gg.w); o8[64 * j] = w; }
    if (copy) { f32x4* c = (f32x4*)copy + lane;
#pragma unroll
        for (int j = 0; j < 8; ++j) c[64 * j] = v[j]; }
}

namespace att {
constexpr int KROW = 272, VROW = 320;
constexpr int L_K = 0, L_V = 17408, L_POS = 58368, L_SK = 58624, L_FLAG = 58880;
constexpr float NEGBIG = -1e30f;
constexpr int D_K = 0, D_V = 34816, D_POS = 75776, D_SK = 76288, D_X = 0;

DI unsigned cvtpk(float lo, float hi) { typedef float f2 __attribute__((ext_vector_type(2))); typedef __bf16 b2 __attribute__((ext_vector_type(2))); f2 v = {lo, hi}; b2 b = __builtin_convertvector(v, b2); return __builtin_bit_cast(unsigned, b); }
DI s16x4 vtr(const LAS char* p) { typedef short v4i16_t __attribute__((ext_vector_type(4))); return __builtin_bit_cast(s16x4, __builtin_amdgcn_ds_read_tr16_b64_v4i16((LAS v4i16_t*)p)); }
DI float hmax(float m) { auto rr = __builtin_amdgcn_permlane32_swap(__float_as_uint(m), __float_as_uint(m), false, false); return fmaxf(__uint_as_float(rr[0]), __uint_as_float(rr[1])); }
DI float hsum(float m) { auto rr = __builtin_amdgcn_permlane32_swap(__float_as_uint(m), __float_as_uint(m), false, false); return __uint_as_float(rr[0]) + __uint_as_float(rr[1]); }
DI float hpartner(float x, int hl) { auto rr = __builtin_amdgcn_permlane32_swap(__float_as_uint(x), __float_as_uint(x), false, false); return __uint_as_float(hl ? rr[0] : rr[1]); }
DI bf16x8 pack8(const f32x16& x, int s) {
    u32x4 p; p.x = cvtpk(x[8 * s], x[8 * s + 1]); p.y = cvtpk(x[8 * s + 2], x[8 * s + 3]); p.z = cvtpk(x[8 * s + 4], x[8 * s + 5]); p.w = cvtpk(x[8 * s + 6], x[8 * s + 7]);
    return __builtin_bit_cast(bf16x8, p);
}
#define MFMA32(a, b, c) __builtin_amdgcn_mfma_f32_32x32x16_bf16((a), (b), (c), 0, 0, 0)

struct Stage { u32x4 k[2], v[2]; int pos; };
DI void stage_load(Stage& st, const bf16_t* kbase, const bf16_t* vbase, const int* posb, int kt, int tid) {
    const unsigned toff = (unsigned)(((tid >> 4) * INC + (tid & 15) * 8) * 2);
    const char* kb_ = (const char*)kbase + (size_t)kt * (64 * INC * 2); const char* vb_ = (const char*)vbase + (size_t)kt * (64 * INC * 2);
    st.k[0] = *(const u32x4*)(kb_ + toff); st.k[1] = *(const u32x4*)(kb_ + 32 * INC * 2 + toff);
    st.v[0] = *(const u32x4*)(vb_ + toff); st.v[1] = *(const u32x4*)(vb_ + 32 * INC * 2 + toff);
    st.pos = (tid < 64) ? posb[kt * 64 + tid] : 0;
}
DI void stage_store(const Stage& st, LAS char* lds, int tid, float slope2, int pos_ref, int voff) {
#pragma unroll
    for (int i = 0; i < 2; ++i) { const int c = tid + 512 * i, row = c >> 4, ch = c & 15;
        *(LAS u32x4*)(lds + L_K + row * KROW + ch * 16) = st.k[i]; *(LAS u32x4*)(lds + voff + row * VROW + ch * 16) = st.v[i]; }
    if (tid < 64) { *(LAS int*)(lds + L_POS + tid * 4) = st.pos; *(LAS float*)(lds + L_SK + tid * 4) = slope2 * (float)(st.pos - pos_ref); }
}
struct Stage2 { u32x4 k[4], v[4]; int pos; };
DI void stage2_load(Stage2& st, const bf16_t* kbase, const bf16_t* vbase, const int* posb, int kt, int tid) {
    const unsigned toff = (unsigned)(((tid >> 4) * INC + (tid & 15) * 8) * 2);
    const char* kb_ = (const char*)kbase + (size_t)kt * (128 * INC * 2); const char* vb_ = (const char*)vbase + (size_t)kt * (128 * INC * 2);
#pragma unroll
    for (int i = 0; i < 4; ++i) { st.k[i] = *(const u32x4*)(kb_ + (size_t)i * (32 * INC * 2) + toff); st.v[i] = *(const u32x4*)(vb_ + (size_t)i * (32 * INC * 2) + toff); }
    st.pos = (tid < 128) ? posb[kt * 128 + tid] : 0;
}
DI void stage2_store(const Stage2& st, LAS char* lds, int tid, float slope2, int pos_ref) {
#pragma unroll
    for (int i = 0; i < 4; ++i) { const int row = (tid >> 4) + 32 * i, ch = tid & 15;
        *(LAS u32x4*)(lds + D_K + row * KROW + ch * 16) = st.k[i]; *(LAS u32x4*)(lds + D_V + row * VROW + ch * 16) = st.v[i]; }
    if (tid < 128) { *(LAS int*)(lds + D_POS + tid * 4) = st.pos; *(LAS float*)(lds + D_SK + tid * 4) = slope2 * (float)(st.pos - pos_ref); }
}
DI bf16x8 scale_frag(const bf16x8 v, float sc) {
    const u32x4 u = __builtin_bit_cast(u32x4, v); u32x4 o;
#pragma unroll
    for (int i = 0; i < 4; ++i) { const float lo = __uint_as_float(u[i] << 16) * sc, hi = __uint_as_float(u[i] & 0xffff0000u) * sc; o[i] = cvtpk(lo, hi); }
    return __builtin_bit_cast(bf16x8, o);
}
DI void pv_acc(f32x16 (&O)[4], const LAS char* vb, const bf16x8 pb00, const bf16x8 pb01, const bf16x8 pb10, const bf16x8 pb11) {
#pragma unroll
    for (int d = 0; d < 4; ++d) {
#pragma unroll
        for (int ss = 0; ss < 4; ++ss) {
            const s16x4 lo = vtr(vb + (ss * 16) * VROW + d * 64), hi = vtr(vb + (ss * 16 + 8) * VROW + d * 64);
            const bf16x8 a = {lo[0], lo[1], lo[2], lo[3], hi[0], hi[1], hi[2], hi[3]};
            const bf16x8 pb = ss == 0 ? pb00 : ss == 1 ? pb01 : ss == 2 ? pb10 : pb11;
            O[d] = MFMA32(a, pb, O[d]);
        }
    }
}

DI void store_rows(LAS char* stg, const f32x16 (&O)[4], float rstd, const float* subg, int hl_, int r32_, int lane_, bf16_t* obase) {
    int lane = lane_; asm volatile("" : "+v"(lane));
    const int hl = lane >> 5, r32 = lane & 31; (void)hl_; (void)r32_;
#pragma unroll
    for (int d = 0; d < 4; ++d)
#pragma unroll
        for (int j = 0; j < 4; ++j) { const int dc = d * 32 + 8 * j + 4 * hl; const f32x4 g4 = *(const f32x4*)(subg + dc);
            u32x2 w; w.x = cvtpk(O[d][4 * j] * rstd * g4.x, O[d][4 * j + 1] * rstd * g4.y); w.y = cvtpk(O[d][4 * j + 2] * rstd * g4.z, O[d][4 * j + 3] * rstd * g4.w);
            *(LAS u32x2*)(stg + r32 * 272 + dc * 2) = w; }
    asm volatile("s_waitcnt lgkmcnt(0)" ::: "memory");
    unsigned voff = (unsigned)(((lane >> 4) * DM + (lane & 15) * 8) * 2);
    asm volatile("" : "+v"(voff));
#pragma unroll
    for (int i = 0; i < 8; ++i) { const u32x4 v = *(const LAS u32x4*)(stg + (i * 4 + (lane >> 4)) * 272 + (lane & 15) * 16);
        *(u32x4*)((char*)obase + (size_t)i * (4 * DM * 2) + voff) = v; }
}

DI void diff_unit(LAS char* lds, const bf16_t* qkv, bf16_t* omix, const int* pos, const int* pmn, const int* pmx, int b, int h, int qb, float lam, float oml, const float* subg, int tid) {
    const int lane = tid & 63, wid = __builtin_amdgcn_readfirstlane(tid >> 6), r32 = lane & 31, hl = lane >> 5, rg = wid >> 1, mp = wid & 1;
    const int q0 = qb * 128, qi = q0 + rg * 32 + r32; const size_t tok = (size_t)b * SEQ + qi;
    const int posq = pos[tok];
    const int* pmnb = pmn + b * 32; const int* pmxb = pmx + b * 32; const int* posb = pos + b * SEQ;
    const int qmax = max(pmxb[q0 >> 6], pmxb[(q0 >> 6) + 1]);
    const int wqmin = pmnb[(q0 + rg * 32) >> 6];
    const int pos_ref = posb[q0];
    const float slope2 = exp2f(-(float)(h + 1)) * LOG2E, scale2 = 0.125f * LOG2E;
    bf16x8 qf[4];
#pragma unroll
    for (int s = 0; s < 4; ++s) qf[s] = scale_frag(*(const bf16x8*)(qkv + tok * INC + C_DQ + h * 128 + mp * 64 + 16 * s + 8 * hl), scale2);
    const bf16_t* kbase = qkv + (size_t)b * SEQ * INC + C_DK + h * 128; const bf16_t* vbase = qkv + (size_t)b * SEQ * INC + C_DV + h * 128;
    float m = -3.0e38f, lsum = 0.f; f32x16 O[4];
#pragma unroll
    for (int d = 0; d < 4; ++d)
#pragma unroll
        for (int r = 0; r < 16; ++r) O[d][r] = 0.f;
    const LAS char* kb0 = lds + D_K + r32 * KROW + mp * 128 + hl * 16;
    const LAS char* vb0 = lds + D_V + (4 * hl + ((lane & 15) >> 2)) * VROW + ((lane >> 4) & 1) * 32 + (lane & 3) * 8;
    const LAS int* pl0 = (const LAS int*)(lds + D_POS);
    const LAS float* skl0 = (const LAS float*)(lds + D_SK);
#define DIFF_FULL(NM0_, NM1_) do { \
        f32x16 p0, p1, p2, p3; \
        _Pragma("unroll") \
        for (int j = 0; j < 4; ++j) { const f32x4 c0 = *(const LAS f32x4*)(skl0 + 8 * j + 4 * hl), c1 = *(const LAS f32x4*)(skl0 + 32 + 8 * j + 4 * hl), \
                                                  c2 = *(const LAS f32x4*)(skl0 + 64 + 8 * j + 4 * hl), c3 = *(const LAS f32x4*)(skl0 + 96 + 8 * j + 4 * hl); \
        _Pragma("unroll") \
            for (int i = 0; i < 4; ++i) { p0[4 * j + i] = c0[i]; p1[4 * j + i] = c1[i]; p2[4 * j + i] = c2[i]; p3[4 * j + i] = c3[i]; } } \
        _Pragma("unroll") \
        for (int s = 0; s < 4; ++s) { \
            const bf16x8 a0 = *(const LAS bf16x8*)(kb0 + s * 32), a1 = *(const LAS bf16x8*)(kb0 + 32 * KROW + s * 32), \
                         a2 = *(const LAS bf16x8*)(kb0 + 64 * KROW + s * 32), a3 = *(const LAS bf16x8*)(kb0 + 96 * KROW + s * 32); \
            p0 = MFMA32(a0, qf[s], p0); p1 = MFMA32(a1, qf[s], p1); p2 = MFMA32(a2, qf[s], p2); p3 = MFMA32(a3, qf[s], p3); } \
        if (NM0_) { \
        _Pragma("unroll") \
            for (int j = 0; j < 4; ++j) { const i32x4 k0 = *(const LAS i32x4*)(pl0 + 8 * j + 4 * hl), k1 = *(const LAS i32x4*)(pl0 + 32 + 8 * j + 4 * hl); \
        _Pragma("unroll") \
                for (int i = 0; i < 4; ++i) { const int r = 4 * j + i; p0[r] = k0[i] <= posq ? p0[r] : NEGBIG; p1[r] = k1[i] <= posq ? p1[r] : NEGBIG; } } \
        } \
        if (NM1_) { \
        _Pragma("unroll") \
            for (int j = 0; j < 4; ++j) { const i32x4 k2 = *(const LAS i32x4*)(pl0 + 64 + 8 * j + 4 * hl), k3 = *(const LAS i32x4*)(pl0 + 96 + 8 * j + 4 * hl); \
        _Pragma("unroll") \
                for (int i = 0; i < 4; ++i) { const int r = 4 * j + i; p2[r] = k2[i] <= posq ? p2[r] : NEGBIG; p3[r] = k3[i] <= posq ? p3[r] : NEGBIG; } } \
        } \
        float mx = fmaxf(fmaxf(p0[0], p1[0]), fmaxf(p2[0], p3[0])); \
        _Pragma("unroll") \
        for (int r = 1; r < 16; ++r) mx = fmaxf(mx, fmaxf(fmaxf(p0[r], p1[r]), fmaxf(p2[r], p3[r]))); \
        mx = hmax(mx); \
        if (__any(mx > m + 8.0f)) { const float mnew = fmaxf(m, mx); const float alpha = __builtin_amdgcn_exp2f(m - mnew); lsum *= alpha; m = mnew; \
        _Pragma("unroll") \
            for (int d = 0; d < 4; ++d) \
        _Pragma("unroll") \
                for (int r = 0; r < 16; ++r) O[d][r] *= alpha; } \
        float ts = 0.f; \
        _Pragma("unroll") \
        for (int r = 0; r < 16; ++r) { p0[r] = __builtin_amdgcn_exp2f(p0[r] - m); p1[r] = __builtin_amdgcn_exp2f(p1[r] - m); ts += p0[r] + p1[r]; } \
        { const bf16x8 pb00 = pack8(p0, 0), pb01 = pack8(p0, 1), pb10 = pack8(p1, 0), pb11 = pack8(p1, 1); \
          pv_acc(O, vb0, pb00, pb01, pb10, pb11); } \
        _Pragma("unroll") \
        for (int r = 0; r < 16; ++r) { p2[r] = __builtin_amdgcn_exp2f(p2[r] - m); p3[r] = __builtin_amdgcn_exp2f(p3[r] - m); ts += p2[r] + p3[r]; } \
        lsum += ts; \
        { const bf16x8 pb00 = pack8(p2, 0), pb01 = pack8(p2, 1), pb10 = pack8(p3, 0), pb11 = pack8(p3, 1); \
          pv_acc(O, vb0 + 64 * VROW, pb00, pb01, pb10, pb11); } \
    } while (0)
#define DIFF_SKIP(n_) (min(pmnb[2 * (n_)], pmnb[2 * (n_) + 1]) > qmax)
#define DIFF_NEXT(k_) ({ int n_ = (k_) + 1; while (n_ < 16 && DIFF_SKIP(n_)) ++n_; n_ < 16 ? n_ : -1; })
    int ta = DIFF_NEXT(-1); Stage2 st;
    if (ta >= 0) stage2_load(st, kbase, vbase, posb, ta, tid);
    while (ta >= 0) {
        __syncthreads();
        stage2_store(st, lds, tid, slope2, pos_ref);
        __syncthreads();
        const int tn = DIFF_NEXT(ta);
        if (tn >= 0) stage2_load(st, kbase, vbase, posb, tn, tid);
        const bool nm0 = pmxb[2 * ta] > wqmin, nm1 = pmxb[2 * ta + 1] > wqmin;
        DIFF_FULL(nm0, nm1);
        ta = tn;
    }
#undef DIFF_FULL
#undef DIFF_SKIP
#undef DIFF_NEXT
    __syncthreads();
    const float inv = 1.0f / hsum(lsum);
    LAS float* X = (LAS float*)(lds + D_X) + rg * 4096;
    if (mp == 1) { const float f = lam * inv;
#pragma unroll
        for (int d = 0; d < 4; ++d)
#pragma unroll
            for (int r = 0; r < 16; ++r) X[(d * 16 + r) * 64 + lane] = O[d][r] * f; }
    __syncthreads();
    if (mp == 0) {
        float ss = 0.f;
#pragma unroll
        for (int d = 0; d < 4; ++d)
#pragma unroll
            for (int r = 0; r < 16; ++r) { const float o = O[d][r] * inv - X[(d * 16 + r) * 64 + lane]; O[d][r] = o; ss += o * o; }
        ss = hsum(ss);
        const float rstd = oml / sqrtf(ss * (1.f / 128.f) + EPS);
        store_rows(lds + 65536 + rg * 8704, O, rstd, subg, hl, r32, lane, omix + ((size_t)b * SEQ + q0 + rg * 32) * DM + h * 128);
    }
}

DI void sb_unit(LAS char* lds, const bf16_t* qkv, bf16_t* omix, const int* pos, const int* pmn, const int* pmx, int b, int h, int qb, const float* subg, int tid) {
    const int lane = tid & 63, wid = __builtin_amdgcn_readfirstlane(tid >> 6), r32 = lane & 31, hl = lane >> 5;
    const int q0 = qb * 256, qi = q0 + wid * 32 + r32; const size_t tok = (size_t)b * SEQ + qi;
    const int posq = pos[tok];
    const int* pmnb = pmn + b * 32; const int* posb = pos + b * SEQ;
    int qmaxu = pmx[b * 32 + (q0 >> 6)];
#pragma unroll
    for (int i = 1; i < 4; ++i) qmaxu = max(qmaxu, pmx[b * 32 + (q0 >> 6) + i]);
    const int wqmax = pmx[b * 32 + ((q0 + 32 * wid) >> 6)];
    const float scale = 0.08838834764831845f;
    bf16x8 qf[8];
#pragma unroll
    for (int s = 0; s < 8; ++s) qf[s] = scale_frag(*(const bf16x8*)(qkv + tok * INC + C_SQ + h * 128 + 16 * s + 8 * hl), scale * LOG2E);
    const bf16_t* kbase = qkv + (size_t)b * SEQ * INC + C_SK + h * 128; const bf16_t* vbase = qkv + (size_t)b * SEQ * INC + C_SV + h * 128;
    float carry = 1.0f; f32x16 O[4];
#pragma unroll
    for (int d = 0; d < 4; ++d)
#pragma unroll
        for (int r = 0; r < 16; ++r) O[d][r] = 0.f;
    const LAS char* vb = lds + L_V + (4 * hl + ((lane & 15) >> 2)) * VROW + ((lane >> 4) & 1) * 32 + (lane & 3) * 8;
    const LAS int* pl = (const LAS int*)(lds + L_POS);
    LAS int* flags = (LAS int*)(lds + L_FLAG);
    if (lane == 0) flags[wid] = 0;
    bool wdone = false;
    int kt = 31; while (kt >= 0 && pmnb[kt] >= qmaxu) --kt;
    Stage st; if (kt >= 0) stage_load(st, kbase, vbase, posb, kt, tid);
    while (kt >= 0) {
        __syncthreads();
        int nd = 0;
#pragma unroll
        for (int w = 0; w < 8; ++w) nd += flags[w];
        if (nd == 8) break;
        stage_store(st, lds, tid, 0.f, 0, L_V);
        __syncthreads();
        int kn = kt - 1; while (kn >= 0 && pmnb[kn] >= qmaxu) --kn;
        if (kn >= 0) stage_load(st, kbase, vbase, posb, kn, tid);
        if (!wdone && pmnb[kt] < wqmax) {
            bf16x8 pbs[2][2];
#pragma unroll
            for (int sub = 1; sub >= 0; --sub) {
                const LAS char* kb = lds + L_K + (sub * 32 + r32) * KROW + hl * 16;
                f32x16 z;
#pragma unroll
                for (int r = 0; r < 16; ++r) z[r] = 0.f;
#pragma unroll
                for (int s = 0; s < 8; ++s) z = MFMA32(*(const LAS bf16x8*)(kb + s * 32), qf[s], z);
                float E[16], G[4], Gp[4];
#pragma unroll
                for (int j = 0; j < 4; ++j) { const i32x4 kp = *(const LAS i32x4*)(pl + sub * 32 + 8 * j + 4 * hl);
                    float kk[4];
#pragma unroll
                    for (int i = 0; i < 4; ++i) { const int r = 4 * j + i; const bool valid = kp[i] < posq;
                        const float e = __builtin_amdgcn_exp2f(-fmaxf(z[r], -120.f)); const float beta = __builtin_amdgcn_rcpf(1.0f + e);
                        kk[i] = valid ? e * beta : 1.0f; z[r] = valid ? beta : 0.f; }
                    E[4 * j + 3] = 1.0f; E[4 * j + 2] = kk[3]; E[4 * j + 1] = kk[3] * kk[2]; E[4 * j] = E[4 * j + 1] * kk[1]; G[j] = E[4 * j] * kk[0]; }
#pragma unroll
                for (int j = 0; j < 4; ++j) Gp[j] = hpartner(G[j], hl);
                const float T3 = G[3] * Gp[3], T2 = (G[2] * Gp[2]) * T3, T1 = (G[1] * Gp[1]) * T2, T0 = (G[0] * Gp[0]) * T1;
                float suf[4]; suf[0] = T1; suf[1] = T2; suf[2] = T3; suf[3] = 1.0f;
#pragma unroll
                for (int j = 0; j < 4; ++j) { if (hl == 0) suf[j] *= Gp[j]; suf[j] *= carry; }
#pragma unroll
                for (int r = 0; r < 16; ++r) z[r] = z[r] * (E[r] * suf[r >> 2]);
                carry *= T0;
                pbs[sub][0] = pack8(z, 0); pbs[sub][1] = pack8(z, 1);
            }
            pv_acc(O, vb, pbs[0][0], pbs[0][1], pbs[1][0], pbs[1][1]);
            wdone = __all(carry < 1e-36f);
            if (lane == 0) flags[wid] = wdone ? 1 : 0;
        }
        kt = kn;
    }
    __syncthreads();
    float ss = 0.f;
#pragma unroll
    for (int d = 0; d < 4; ++d)
#pragma unroll
        for (int r = 0; r < 16; ++r) ss += O[d][r] * O[d][r];
    ss = hsum(ss);
    const float rstd = 1.0f / sqrtf(ss * (1.f / 128.f) + EPS);
    store_rows(lds + 61440 + wid * 8704, O, rstd, subg, hl, r32, lane, omix + ((size_t)b * SEQ + q0 + wid * 32) * DM + 1024 + h * 128);
    __syncthreads();
}
}

constexpr int NWAVES = 8;
constexpr int LDS_BYTES = 147456;
constexpr int PH_PER_LAYER = 7, N_PHASES = 3 + NLAYER * PH_PER_LAYER + 1;
struct Args { const void* in[21]; float* out; unsigned char* ws; int ph_lo, ph_hi; };

DI const void* karg(int i) {
    const __attribute__((address_space(1))) char* p;
    asm volatile("s_load_dwordx2 %0, %1, %2\n\ts_waitcnt lgkmcnt(0)" : "=s"(p) : "s"(__builtin_amdgcn_kernarg_segment_ptr()), "i"(i * 8));
    return (const void*)p;
}
#define KIN(i) karg(i)
#define KOUT ((float*)karg(21))
#define KWS ((unsigned char*)karg(22))

#define XB_TMO      128
#define XB_XCNT(j)  (256  + 64 * (j))
#define XB_XSUB(j)  (1280 + 64 * (j))
#define XB_XGEN(j)  (2304 + 64 * (j))
#define XB_TOP      3328
#define XB_TOPGEN   3392
#define XCD_BAR_WORDS 3456
#define XB_SPIN_CAP (1u << 20)
DI unsigned xb_ld(unsigned* p)              { return __hip_atomic_load(p, __ATOMIC_RELAXED, __HIP_MEMORY_SCOPE_AGENT); }
DI unsigned xb_add(unsigned* p, unsigned v) { return __hip_atomic_fetch_add(p, v, __ATOMIC_RELAXED, __HIP_MEMORY_SCOPE_AGENT); }
DI unsigned xb_xcc_id() { return (unsigned)__builtin_amdgcn_s_getreg((3 << 11) | 20) & 0xFu; }
#define XB_SPIN(cond, bar) do { unsigned _sp = 0; while (cond) { __builtin_amdgcn_s_sleep(1); \
    if ((++_sp & 255u) == 0u) { if (xb_ld(&(bar)[XB_TMO])) break; if (_sp > XB_SPIN_CAP) { atomicAdd(&(bar)[XB_TMO], 1u); break; } } } } while (0)
DI void xcd_barrier_complete(unsigned* bar, unsigned x, unsigned& nloc, unsigned& nx) {
    const unsigned G = gridDim.x;
    unsigned sum, cnt, mine, sp = 0u;
    for (;;) {
        sum = 0u; cnt = 0u; mine = 0u;
#pragma unroll
        for (unsigned j = 0; j < 16; ++j) { const unsigned c = xb_ld(&bar[XB_XCNT(j)]); sum += c; cnt += (c > 0u) ? 1u : 0u; mine = (j == x) ? c : mine; }
        if (sum == G) break;
        __builtin_amdgcn_s_sleep(1);
        if ((++sp & 255u) == 0u) { if (xb_ld(&bar[XB_TMO])) break; if (sp > XB_SPIN_CAP) { atomicAdd(&bar[XB_TMO], 1u); break; } }
    }
    nloc = mine > 0u ? mine : 1u; nx = cnt > 0u ? cnt : 1u;
}
constexpr int LDS_MISC = 147456 - 64;
DI void grid_bar(unsigned& nbar) {
    asm volatile("s_waitcnt vmcnt(0)" ::: "memory");
    __syncthreads();
    if (threadIdx.x == 0) {
        unsigned* bar = (unsigned*)(KWS + WS_SMALL + 16384);
        volatile LAS unsigned* st = (volatile LAS unsigned*)(LDS_MISC);
        const unsigned x = xb_xcc_id();
        __builtin_amdgcn_s_waitcnt(0);
        unsigned nloc = st[0], nx = st[1];
        if (nloc == 0u) { xcd_barrier_complete(bar, x, nloc, nx); st[0] = nloc; st[1] = nx; }
        const unsigned old = xb_add(&bar[XB_XSUB(x)], 1u);
        const unsigned gen = old / nloc;
        if (old + 1u == (gen + 1u) * nloc) {
            __builtin_amdgcn_fence(__ATOMIC_RELEASE, "agent");
            asm volatile("s_waitcnt vmcnt(0)" ::: "memory");
            const unsigned og = xb_add(&bar[XB_TOP], 1u);
            const unsigned tg = og / nx;
            if (og + 1u == (tg + 1u) * nx) xb_add(&bar[XB_TOPGEN], 1u);
            else XB_SPIN(xb_ld(&bar[XB_TOPGEN]) == tg, bar);
            __builtin_amdgcn_fence(__ATOMIC_ACQUIRE, "agent");
            xb_add(&bar[XB_XGEN(x)], 1u);
            asm volatile("s_waitcnt vmcnt(0)" ::: "memory");
        } else {
            XB_SPIN(xb_ld(&bar[XB_XGEN(x)]) == gen, bar);
            __builtin_amdgcn_fence(__ATOMIC_ACQUIRE, "agent");
            asm volatile("s_waitcnt vmcnt(0)" ::: "memory");
        }
    }
    __syncthreads();
    nbar += 1u;
}
struct EpiFinal {
    static constexpr bool PERM = true;
    const bf16_t* HB; float* out; int ldc; float* ss; const float* g;
    DI void operator()(const pg8::f32x4 (&acc)[2][2][4][2], const pg8::Unit& u, int wr, int wc, int fr, int fq) const {
        const int row0 = u.pm * pg8::BM + wr * 64 + fr; const int col0 = u.pn * pg8::BM + wc * 32 + 8 * fq;
        f32x4 v[2][4][2][2];
#pragma unroll
        for (int ai = 0; ai < 2; ++ai)
#pragma unroll
            for (int m = 0; m < 4; ++m) { const int row = row0 + ai * pg8::HALF + m * 16; const size_t off = (size_t)row * ldc + col0; float s = 0.f;
#pragma unroll
                for (int bj = 0; bj < 2; ++bj) { const u32x4 h = *(const u32x4*)(HB + off + bj * pg8::HALF);
                    const f32x4 p0 = {__uint_as_float(h.x << 16), __uint_as_float(h.x & 0xffff0000u), __uint_as_float(h.y << 16), __uint_as_float(h.y & 0xffff0000u)};
                    const f32x4 p1 = {__uint_as_float(h.z << 16), __uint_as_float(h.z & 0xffff0000u), __uint_as_float(h.w << 16), __uint_as_float(h.w & 0xffff0000u)};
                    const f32x4 v0 = p0 + acc[ai][bj][m][0], v1 = p1 + acc[ai][bj][m][1]; v[ai][m][bj][0] = v0; v[ai][m][bj][1] = v1;
                    s += ((v0[0] * v0[0] + v0[1] * v0[1]) + (v0[2] * v0[2] + v0[3] * v0[3])) + ((v1[0] * v1[0] + v1[1] * v1[1]) + (v1[2] * v1[2] + v1[3] * v1[3])); }
                s += __shfl_xor(s, 16); s += __shfl_xor(s, 32);
                if (fq == 0) ss[(size_t)row * 32 + u.pn * 4 + wc] = s; }
        unsigned dummy = 0u; grid_bar(dummy);
#pragma unroll
        for (int bj = 0; bj < 2; ++bj) { const f32x4 g0 = *(const f32x4*)(g + col0 + bj * pg8::HALF), g1 = *(const f32x4*)(g + col0 + bj * pg8::HALF + 4);
#pragma unroll
            for (int ai = 0; ai < 2; ++ai)
#pragma unroll
                for (int m = 0; m < 4; ++m) { const int row = row0 + ai * pg8::HALF + m * 16; const float rs = 1.0f / sqrtf(pg8::row_ss(ss, row, fq) * (1.f / 2048.f) + 1e-6f);
                    float* o = out + (size_t)row * ldc + col0 + bj * pg8::HALF; *(f32x4*)o = v[ai][m][bj][0] * rs * g0; *(f32x4*)(o + 4) = v[ai][m][bj][1] * rs * g1; } }
    }
};

constexpr int CV_IN = 32 * 96, CV_SQ = 32 * 32, CV_WQ = DM, CV_KV = 32 * 64, CV_UP = 32 * 128, CV_DN = 128 * 32;
constexpr int CV_LAYER = CV_IN + 2 * CV_SQ + CV_WQ + CV_KV + CV_UP + CV_DN;
constexpr int CV_L1_LO = CV_IN + CV_SQ, CV_L1_HI = CV_IN + 2 * CV_SQ + CV_WQ + CV_KV;
DI void conv_item(int l, int r, LAS float* scr, int lane) {
    unsigned char* wt = KWS + WS_WT + (size_t)l * WT_LAYER;
    if (r < CV_IN) { transpose_item((const float*)KIN(4) + (size_t)l * DM * INC, DM, INC, (bf16_t*)(wt + WT_IN), scr, r, lane, (const float*)KIN(3) + l * DM); return; } r -= CV_IN;
    if (r < CV_SQ) { transpose_item((const float*)KIN(11) + (size_t)l * DM * DM, DM, DM, (bf16_t*)(wt + WT_OUT), scr, r, lane, nullptr); return; } r -= CV_SQ;
    if (r < CV_WQ) { scaled_row_bf16((const float*)KIN(14) + (size_t)l * DM * DM + (size_t)r * DM, ((const float*)KIN(12))[l * DM + r], (bf16_t*)(wt + WT_Q) + (size_t)r * DM, lane); return; } r -= CV_WQ;
    if (r < CV_KV) { transpose_item((const float*)KIN(15) + (size_t)l * DM * 2 * DM, DM, 2 * DM, (bf16_t*)(wt + WT_KV), scr, r, lane, nullptr); return; } r -= CV_KV;
    if (r < CV_SQ) { transpose_item((const float*)KIN(16) + (size_t)l * DM * DM, DM, DM, (bf16_t*)(wt + WT_O), scr, r, lane, nullptr); return; } r -= CV_SQ;
    if (r < CV_UP) { transpose_item((const float*)KIN(18) + (size_t)l * DM * FF, DM, FF, (bf16_t*)(wt + WT_UP), scr, r, lane, (const float*)KIN(17) + l * DM); return; } r -= CV_UP;
    transpose_item((const float*)KIN(19) + (size_t)l * FF * DM, FF, DM, (bf16_t*)(wt + WT_DOWN), scr, r, lane, nullptr);
}
DI void conv_idle(int first, int lo_, int hi_, LAS unsigned char* lds, int layer = 1) {
    const int tid = threadIdx.x, lane = tid & 63, wave = __builtin_amdgcn_readfirstlane(tid >> 6);
    const int nb = (int)gridDim.x - first; if ((int)gridDim.x < 256 || (int)blockIdx.x < first || nb <= 0) return;
    LAS float* scr = (LAS float*)(lds + wave * 16640);
    for (int it = lo_ + ((int)blockIdx.x - first) * NWAVES + wave; it < hi_; it += nb * NWAVES) conv_item(layer, it, scr, lane);
}

typedef pg8::ZNone ZN;

#define IN(k) (lo <= (k) && (k) < hi)
#define SEAM(k) do { if (IN(k) && IN((k) + 1)) grid_bar(nbar); } while (0)

template <int L>
DI void layer_fwd(LAS unsigned char* lds, unsigned& nbar, const int lo, const int hi) {
    const int tid = threadIdx.x, lane = tid & 63, wave = __builtin_amdgcn_readfirstlane(tid >> 6);
    const int G = gridDim.x, bx = blockIdx.x;
    const int gw = bx * NWAVES + wave, NGW = G * NWAVES;
    constexpr int P0 = 3 + L * PH_PER_LAYER;
#define WSP(T, off) ((T*)(KWS + (off)))
#define WTP(off) ((const bf16_t*)(KWS + WS_WT + (size_t)L * WT_LAYER + (off)))
#define SSP(i) ((float*)(KWS + WS_SS) + (size_t)(i) * TOK * 32)
#define hbuf KOUT
    if (IN(P0 + 0)) {
        pg8::EpiBf16<ZN> E{WSP(bf16_t, WS_RA), INC, 0, SSP(3 * L)}; pg8::Order S; S.init(TOK, INC, 1, G, bx);
        pg8::gemm_phase<pg8::EpiBf16<ZN>, DM, DM, DM, ZN, ZN>(lds, WSP(bf16_t, WS_XN), WTP(WT_IN), S, E);
    }
    SEAM(P0 + 0);
    if (IN(P0 + 1)) {
        const int* pos = (const int*)KIN(2); const int* pmn = WSP(int, WS_SMALL); const int* pmx = pmn + 128;
        const bf16_t* QKV = WSP(bf16_t, WS_RA); bf16_t* OMIX = WSP(bf16_t, WS_RA + 96 * MiB);
        const float li = 0.8f - 0.6f * expf(-0.3f * (float)L);
        const float* lq1 = (const float*)KIN(5) + L * 64; const float* lk1 = (const float*)KIN(6) + L * 64;
        const float* lq2 = (const float*)KIN(7) + L * 64; const float* lk2 = (const float*)KIN(8) + L * 64;
        float d1 = 0.f, d2 = 0.f;
        for (int i = 0; i < 64; ++i) { d1 += lq1[i] * lk1[i]; d2 += lq2[i] * lk2[i]; }
        const float lam = expf(d1) - expf(d2) + li;
        const float* sgd = (const float*)KIN(9) + L * 128; const float* sgs = (const float*)KIN(10) + L * 128;
        const int vcu = (G % 8 == 0) ? (bx % 8) * (G / 8) + bx / 8 : bx;
        for (int u = vcu; u < 256; u += G) { const int bh = u >> 3, sx = u & 7;
            for (int half = 0; half < 2; ++half)
                att::diff_unit((LAS char*)lds, QKV, OMIX, pos, pmn, pmx, bh >> 3, bh & 7, half == 0 ? 15 - sx : sx, lam, 1.0f - li, sgd, tid); }
        __syncthreads();
        for (int u = vcu; u < 256; u += G) { const int bh = u >> 3, qb = u & 7;
            att::sb_unit((LAS char*)lds, QKV, OMIX, pos, pmn, pmx, bh >> 3, bh & 7, qb, sgs, tid); }
    }
    SEAM(P0 + 1);
    if (IN(P0 + 2)) {
        pg8::EpiResid E{(L == 0) ? (const float*)KIN(0) : (const float*)nullptr, WSP(bf16_t, WS_XN), DM, SSP(3 * L + 1), 0}; pg8::Order S; S.init(TOK, DM, 1, G, bx);
        pg8::gemm_phase<pg8::EpiResid, DM, DM, DM, ZN, ZN>(lds, WSP(bf16_t, WS_RA + 96 * MiB), WTP(WT_OUT), S, E);
    }
    SEAM(P0 + 2);
    if (IN(P0 + 3)) {
        typedef pg8::ZOffT<1, (long)SEQ * DM, 0> ZXB; typedef pg8::ZOffT<1, (long)1024 * DM, 0> ZQB; typedef pg8::ZOffT<1, (long)SEQ * 1024, 0> ZPB;
        pg8::EpiSoftmax<ZPB> E{WSP(bf16_t, WS_RA + 64 * MiB), 1024, 0.044194173824159216f * LOG2E, SSP(3 * L + 1), SEQ}; pg8::Order S; S.init(SEQ, 1024, NB, G, bx);
        pg8::gemm_phase<pg8::EpiSoftmax<ZPB>, DM, DM, DM, ZXB, ZQB>(lds, WSP(bf16_t, WS_XN), WSP(bf16_t, WS_QKW + (size_t)L * 16 * MiB), S, E);
        if (L == 0) { conv_idle(128, CV_LAYER - CV_DN / 2, CV_LAYER, lds, 0);
                      conv_idle(128, CV_L1_HI, CV_L1_HI + CV_UP, lds); }
        else conv_idle(128, CV_L1_HI + CV_UP, CV_LAYER, lds);
    }
    SEAM(P0 + 3);
    if (IN(P0 + 4)) {
        typedef pg8::ZOffT<1, (long)SEQ * 1024, 0> ZPB;
        pg8::EpiResid E{nullptr, WSP(bf16_t, WS_XN), DM, SSP(3 * L + 2), SEQ}; pg8::Order S; S.init(SEQ, DM, NB, G, bx);
        pg8::gemm_phase<pg8::EpiResid, 1024, 1024, 1024, ZPB, ZPB>(lds, WSP(bf16_t, WS_RA + 64 * MiB), WSP(bf16_t, WS_VW + (size_t)L * 16 * MiB), S, E);
    }
    SEAM(P0 + 4);
    if (IN(P0 + 5)) {
        pg8::EpiBf16<ZN> E{WSP(bf16_t, WS_RA), FF, 1, SSP(3 * L + 2)}; pg8::Order S; S.init(TOK, FF, 1, G, bx);
        pg8::gemm_phase<pg8::EpiBf16<ZN>, DM, DM, DM, ZN, ZN>(lds, WSP(bf16_t, WS_XN), WTP(WT_UP), S, E);
    }
    SEAM(P0 + 5);
    const bool fuse_final = (L == NLAYER - 1) && G == 256 && IN(P0 + 6) && IN(P0 + 7);
    if (IN(P0 + 6)) {
        pg8::Order S; S.init(TOK, DM, 1, G, bx);
        if (fuse_final) {
            EpiFinal E{WSP(bf16_t, WS_XN), hbuf, DM, SSP(3 * L + 3), (const float*)KIN(20)};
            pg8::gemm_phase<EpiFinal, FF, FF, FF, ZN, ZN>(lds, WSP(bf16_t, WS_RA), WTP(WT_DOWN), S, E);
        } else {
            pg8::EpiResid E{nullptr, WSP(bf16_t, WS_XN), DM, SSP(3 * L + 3), 0};
            pg8::gemm_phase<pg8::EpiResid, FF, FF, FF, ZN, ZN>(lds, WSP(bf16_t, WS_RA), WTP(WT_DOWN), S, E);
        }
    }
    if (!fuse_final) {
        SEAM(P0 + 6);
        if (L == NLAYER - 1) {
            if (IN(P0 + 7)) { const float* gsel = (const float*)KIN(20); const float* ssf = SSP(3 * NLAYER);
                for (int m = gw; m < TOK; m += NGW) scale_row_out(WSP(bf16_t, WS_XN) + (size_t)m * DM, hbuf + (size_t)m * DM, gsel, wave_sum(lane < 32 ? ssf[(size_t)m * 32 + lane] : 0.f), lane); }
        }
    }
#undef WSP
#undef WTP
#undef SSP
#undef hbuf
}

__global__ void __launch_bounds__(NWAVES * 64, 2) mega_fwd(Args args) {
    extern __shared__ __attribute__((aligned(16))) unsigned char lds_raw[];
    LAS unsigned char* lds = (LAS unsigned char*)lds_raw;
    cg::grid_group grid = cg::this_grid();
    const int lo = args.ph_lo, hi = args.ph_hi;
    if (threadIdx.x == 0) { volatile LAS unsigned* st = (volatile LAS unsigned*)(LDS_MISC); st[0] = 0u; st[1] = 0u;
        (void)xb_add(&((unsigned*)(KWS + WS_SMALL + 16384))[XB_XCNT(xb_xcc_id())], 1u); }
    __syncthreads();
    if (IN(0)) {
        const int tid = threadIdx.x, lane = tid & 63, wave = __builtin_amdgcn_readfirstlane(tid >> 6);
        const int gw = blockIdx.x * NWAVES + wave, NGW = gridDim.x * NWAVES;
        unsigned char* const ws = KWS;
        LAS float* scr = (LAS float*)(lds + wave * 16640);
        constexpr int CV_P0 = CV_LAYER - CV_DN / 2;
        if (gridDim.x >= 256) { for (int it = gw; it < CV_P0 + (CV_L1_HI - CV_L1_LO); it += NGW) { if (it < CV_P0) conv_item(0, it, scr, lane); else conv_item(1, CV_L1_LO + it - CV_P0, scr, lane); } }
        else { for (int it = gw; it < 2 * CV_LAYER; it += NGW) conv_item(it / CV_LAYER, it % CV_LAYER, scr, lane); }
        const float* x = (const float*)KIN(0); const float* mem = (const float*)KIN(1); const int* pos = (const int*)KIN(2);
        float* ssb = (float*)(ws + WS_SS);
        for (int m = gw; m < TOK; m += NGW) prep_row(x + (size_t)m * DM, (bf16_t*)(ws + WS_XN) + (size_t)m * DM, ssb + (size_t)m * 32, lane);
        for (int m = gw; m < NLAYER * NB * NMEM; m += NGW) { const int l = m / (NB * NMEM), r = m % (NB * NMEM);
            rms_row_bf16(mem + (size_t)r * DM, (const float*)KIN(13) + l * DM, (bf16_t*)(ws + WS_MEMN + (size_t)l * 4 * MiB) + (size_t)r * DM, nullptr, lane); }
        int* pmn = (int*)(ws + WS_SMALL); int* pmx = pmn + 128;
        for (int m = gw; m < 128; m += NGW) { const int p = pos[m * 64 + lane]; const int mn = wave_mini(p), mx = wave_maxi(p); if (lane == 0) { pmn[m] = mn; pmx[m] = mx; } }
    }
    unsigned nbar = 0u;
    if (lo < 0) grid.sync();
    SEAM(0);
    if (IN(1)) {
        const int bx = blockIdx.x;
        if (bx < 128) {
            const int l = bx >> 6; unsigned char* const ws = KWS;
            pg8::EpiBf16<ZN> E{(bf16_t*)(ws + WS_KVX + (size_t)l * 8 * MiB), 2 * DM, 0, nullptr};
            pg8::Order S; S.init(NB * NMEM, 2 * DM, 1, 64, bx & 63);
            pg8::gemm_phase<pg8::EpiBf16<ZN>, DM, DM, DM, ZN, ZN>(lds, (const bf16_t*)(ws + WS_MEMN + (size_t)l * 4 * MiB), (const bf16_t*)(ws + WS_WT + (size_t)l * WT_LAYER + WT_KV), S, E);
        }
        conv_idle(128, 0, CV_L1_LO, lds);
    }
    SEAM(1);
    if (IN(2)) {
        const int bx = blockIdx.x; unsigned char* const ws = KWS;
        typedef pg8::ZOffT<4, (long)NMEM * 4096, 512> ZKV;
        typedef pg8::ZOffT<4, 0, 512> ZHD;
        typedef pg8::ZOffT<4, (long)1024 * DM, (long)NMEM * DM> ZQKW;
        typedef pg8::ZOffT<4, (long)SEQ * 1024, 256> ZVW;
        for (int l = 0; l < NLAYER; ++l) {
            const bf16_t* kvx = (const bf16_t*)(ws + WS_KVX + (size_t)l * 8 * MiB);
            if (bx < 128) {
                pg8::EpiBf16<ZQKW> E{(bf16_t*)(ws + WS_QKW + (size_t)l * 16 * MiB), DM, 0, nullptr};
                pg8::Order S; S.init(NMEM, DM, 16, 128, bx);
                pg8::gemm_phase<pg8::EpiBf16<ZQKW>, 512, 4096, DM, ZKV, ZHD>(lds, kvx, (const bf16_t*)(ws + WS_WT + (size_t)l * WT_LAYER + WT_Q), S, E);
            } else {
                pg8::EpiBf16<ZVW> E{(bf16_t*)(ws + WS_VW + (size_t)l * 16 * MiB), 1024, 0, nullptr};
                pg8::Order S; S.init(DM, NMEM, 16, 128, bx - 128);
                pg8::gemm_phase<pg8::EpiBf16<ZVW>, 512, DM, 4096, ZHD, ZKV>(lds, (const bf16_t*)(ws + WS_WT + (size_t)l * WT_LAYER + WT_O), kvx + DM, S, E);
            }
        }
    }
    layer_fwd<0>(lds, nbar, lo, hi);
    layer_fwd<1>(lds, nbar, lo, hi);
}

extern "C" void kernel_launch(void* const* d_in, const int* in_sizes, int n_in, void* d_out, int out_size, void* d_ws, size_t ws_size, hipStream_t stream) {
    static int grid = 0;
    if (grid == 0) {
        if (n_in != 21 || out_size != TOK * DM || ws_size < WS_END) { fprintf(stderr, "kernel_launch: unexpected shapes (n_in %d out %d ws %zu)\n", n_in, out_size, ws_size); grid = -1; return; }
        int dev = 0, cus = 0, per_cu = 0;
        hipGetDevice(&dev); hipDeviceGetAttribute(&cus, hipDeviceAttributeMultiprocessorCount, dev);
        hipFuncSetAttribute((const void*)mega_fwd, hipFuncAttributeMaxDynamicSharedMemorySize, LDS_BYTES);
        hipOccupancyMaxActiveBlocksPerMultiprocessor(&per_cu, (const void*)mega_fwd, NWAVES * 64, LDS_BYTES);
        if (per_cu < 1) { fprintf(stderr, "kernel_launch: occupancy query says %d blocks per CU\n", per_cu); per_cu = 1; }
        (void)hipGetLastError();
        grid = cus * per_cu;
    }
    if (grid < 0) return;
    if (hipMemsetAsync((char*)d_ws + WS_SMALL + 16384, 0, XCD_BAR_WORDS * 4, stream) != hipSuccess) { fprintf(stderr, "kernel_launch: memset failed\n"); return; }
    Args a{};
    for (int i = 0; i < 21; ++i) a.in[i] = d_in[i];
    a.out = (float*)d_out; a.ws = (unsigned char*)d_ws; a.ph_lo = 0; a.ph_hi = N_PHASES;
    void* kargs[] = {&a};
    hipError_t e = hipLaunchCooperativeKernel((const void*)mega_fwd, dim3(grid), dim3(NWAVES * 64), kargs, LDS_BYTES, stream);
    if (e != hipSuccess) fprintf(stderr, "cooperative launch failed: %s (grid %d)\n", hipGetErrorString(e), grid);
}
```
